# Optimizing an MI355X kernel written in HIP

```python
import jax, jax.numpy as jnp
from jax import lax
import numpy as np

D_MODEL = 2048
BATCH = 8
SEQ = 2048
DEPTH = 2

N_MIXERS = 2
GRID_W = 64
NORM_EPS = 1e-6

MLSTM_HEADS = 4
MLSTM_V_DIM = D_MODEL // MLSTM_HEADS
MLSTM_QK_DIM = MLSTM_V_DIM // 2
MLSTM_CHUNK = 128
MLSTM_F_BIAS_LO = 3.0
MLSTM_F_BIAS_HI = 6.0
MLSTM_IN = 2 * MLSTM_HEADS * MLSTM_QK_DIM + 2 * MLSTM_HEADS * MLSTM_V_DIM + 4 * MLSTM_HEADS

ATTN_HEAD_DIM = 128
ATTN_Q_HEADS = D_MODEL // ATTN_HEAD_DIM
ATTN_KV_HEADS = 4
ATTN_GROUPS = ATTN_Q_HEADS // ATTN_KV_HEADS
ATTN_Q_BLOCK = 128
ROPE_THETA = 10000.0
ATTN_IN = (ATTN_Q_HEADS + 2 * ATTN_KV_HEADS) * ATTN_HEAD_DIM

PEER_HEADS = 8
PEER_N_KEYS = 128
PEER_EXPERTS = PEER_N_KEYS ** 2
PEER_TOPK = 16
PEER_QUERY_DIM = 256
PEER_HALF = PEER_QUERY_DIM // 2
PEER_TOKEN_BLOCK = 128
PEER_V_SCALE = PEER_HEADS ** -0.5

kernel_name = "hybrid_mlstm_axialgqa_peer_encoder"


def rms_norm(x, g):
    xf = x.astype(jnp.float32)
    y = xf * lax.rsqrt(jnp.mean(xf * xf, axis=-1, keepdims=True) + NORM_EPS)
    return (y * g.astype(jnp.float32)).astype(x.dtype)


def mlstm_chunkwise(q, k, v, ig, fg):
    B, H, S, dk = q.shape
    dv = v.shape[-1]
    L = MLSTM_CHUNK
    nc = S // L

    def chunks(a):
        return jnp.moveaxis(a.reshape(B, H, nc, L, *a.shape[3:]), 2, 0)

    lower = jnp.tril(jnp.ones((L, L), dtype=bool))

    def step(carry, inp):
        C, n, m = carry
        q_, k_, v_, i_, f_ = inp
        b = jnp.cumsum(jax.nn.log_sigmoid(f_), axis=-1)
        log_d = jnp.where(lower, b[..., :, None] - b[..., None, :] + i_[..., None, :], -jnp.inf)
        m_inter = b + m[..., None]
        m_t = jnp.maximum(m_inter, jnp.max(log_d, axis=-1))
        dmat = jnp.exp(log_d - m_t[..., None])
        inter = jnp.exp(m_inter - m_t)
        s = jnp.einsum('bhtd,bhsd->bhts', q_, k_) * dmat
        num = jnp.einsum('bhts,bhsv->bhtv', s, v_) + inter[..., None] * jnp.einsum('bhvd,bhtd->bhtv', C, q_)
        den = jnp.sum(s, axis=-1) + inter * jnp.einsum('bhd,bhtd->bht', n, q_)
        h = num / jnp.maximum(jnp.abs(den), jnp.exp(-m_t))[..., None]
        b_last = b[..., -1]
        log_w = b_last[..., None] - b + i_
        m_new = jnp.maximum(b_last + m, jnp.max(log_w, axis=-1))
        w = jnp.exp(log_w - m_new[..., None])
        decay = jnp.exp(b_last + m - m_new)
        C = decay[..., None, None] * C + jnp.einsum('bhs,bhsv,bhsd->bhvd', w, v_, k_)
        n = decay[..., None] * n + jnp.einsum('bhs,bhsd->bhd', w, k_)
        return (C, n, m_new), h

    init = (jnp.zeros((B, H, dv, dk), jnp.float32),
            jnp.zeros((B, H, dk), jnp.float32),
            jnp.zeros((B, H), jnp.float32))
    _, h = lax.scan(step, init, (chunks(q), chunks(k), chunks(v), chunks(ig), chunks(fg)))
    return jnp.moveaxis(h, 0, 2).reshape(B, H, S, dv)


def mlstm_mixer(xn, w_in, gate_bias, head_norm, w_out):
    B, S, _ = xn.shape
    H = MLSTM_HEADS
    nqk = H * MLSTM_QK_DIM
    nv = H * MLSTM_V_DIM
    proj = xn @ w_in
    q, k, v, o, gates = jnp.split(proj, [nqk, 2 * nqk, 2 * nqk + nv, 2 * nqk + 2 * nv], axis=-1)

    def heads(a, d):
        return a.reshape(B, S, H, d).transpose(0, 2, 1, 3).astype(jnp.float32)

    q = heads(q, MLSTM_QK_DIM) * (MLSTM_QK_DIM ** -0.5)
    k = heads(k, MLSTM_QK_DIM)
    v = heads(v, MLSTM_V_DIM)
    g = (gates.reshape(B, S, 4, H).astype(jnp.float32) + gate_bias.astype(jnp.float32)).transpose(2, 0, 3, 1)
    h_fwd = mlstm_chunkwise(q, k, v, g[0], g[1])
    flip = lambda a: jnp.flip(a, axis=2)
    h_bwd = flip(mlstm_chunkwise(flip(q), flip(k), flip(v), flip(g[2]), flip(g[3])))
    h = h_fwd + h_bwd
    h = h * lax.rsqrt(jnp.mean(h * h, axis=-1, keepdims=True) + NORM_EPS) * head_norm.astype(jnp.float32)[None, :, None, :]
    h = h.transpose(0, 2, 1, 3).reshape(B, S, nv) * jax.nn.sigmoid(o.astype(jnp.float32))
    return h.astype(xn.dtype) @ w_out


def axial_rope(S):
    rows = S // GRID_W
    row = jnp.repeat(jnp.arange(rows, dtype=jnp.float32), GRID_W)
    col = jnp.tile(jnp.arange(GRID_W, dtype=jnp.float32), rows)
    n_freq = ATTN_HEAD_DIM // 4
    freqs = ROPE_THETA ** (-jnp.arange(n_freq, dtype=jnp.float32) / n_freq)
    ang = jnp.concatenate([row[:, None] * freqs, col[:, None] * freqs], axis=-1)
    return jnp.cos(ang), jnp.sin(ang)


def apply_rope(x, cos, sin):
    xp = x.reshape(*x.shape[:-1], -1, 2)
    x1, x2 = xp[..., 0], xp[..., 1]
    c = cos[None, :, None, :]
    s = sin[None, :, None, :]
    return jnp.stack([x1 * c - x2 * s, x1 * s + x2 * c], axis=-1).reshape(x.shape)


def attn_mixer(xn, w_in, q_norm, k_norm, w_out):
    B, S, _ = xn.shape
    nq = ATTN_Q_HEADS * ATTN_HEAD_DIM
    nkv = ATTN_KV_HEADS * ATTN_HEAD_DIM
    proj = xn @ w_in
    q, k, v = jnp.split(proj, [nq, nq + nkv], axis=-1)
    cos, sin = axial_rope(S)
    q = apply_rope(rms_norm(q.reshape(B, S, ATTN_Q_HEADS, ATTN_HEAD_DIM), q_norm).astype(jnp.float32), cos, sin)
    k = apply_rope(rms_norm(k.reshape(B, S, ATTN_KV_HEADS, ATTN_HEAD_DIM), k_norm).astype(jnp.float32), cos, sin)
    q = (q * (ATTN_HEAD_DIM ** -0.5)).astype(xn.dtype)
    k = k.astype(xn.dtype)
    v = v.reshape(B, S, ATTN_KV_HEADS, ATTN_HEAD_DIM)
    nb = S // ATTN_Q_BLOCK
    qb = jnp.moveaxis(q.reshape(B, nb, ATTN_Q_BLOCK, ATTN_KV_HEADS, ATTN_GROUPS, ATTN_HEAD_DIM), 1, 0)

    def block(q_blk):
        s = jnp.einsum('bqkgd,bskd->bkgqs', q_blk, k, preferred_element_type=jnp.float32)
        p = jax.nn.softmax(s, axis=-1).astype(v.dtype)
        return jnp.einsum('bkgqs,bskd->bqkgd', p, v)

    o = lax.map(block, qb)
    o = jnp.moveaxis(o, 0, 1).reshape(B, S, nq)
    return o @ w_out


def peer(xn, wq, k1, k2, u, v):
    B, S, D = xn.shape
    q = (xn @ wq).reshape(B, S, PEER_HEADS, 2, PEER_HALF)
    s1 = jnp.einsum('bshd,nd->bshn', q[..., 0, :], k1, preferred_element_type=jnp.float32)
    s2 = jnp.einsum('bshd,nd->bshn', q[..., 1, :], k2, preferred_element_type=jnp.float32)
    t1, i1 = lax.top_k(s1, PEER_TOPK)
    t2, i2 = lax.top_k(s2, PEER_TOPK)
    cand_s = (t1[..., :, None] + t2[..., None, :]).reshape(B, S, PEER_HEADS, PEER_TOPK * PEER_TOPK)
    cand_i = (i1[..., :, None] * PEER_N_KEYS + i2[..., None, :]).reshape(B, S, PEER_HEADS, PEER_TOPK * PEER_TOPK)
    top_s, pos = lax.top_k(cand_s, PEER_TOPK)
    idx = jnp.take_along_axis(cand_i, pos, axis=-1)
    gate = jax.nn.softmax(top_s, axis=-1)
    nblk = (B * S) // PEER_TOKEN_BLOCK
    E = PEER_HEADS * PEER_TOPK
    xb = xn.reshape(nblk, PEER_TOKEN_BLOCK, D)
    ib = idx.reshape(nblk, PEER_TOKEN_BLOCK, E)
    gb = gate.reshape(nblk, PEER_TOKEN_BLOCK, E)

    def block(args):
        x_blk, i_blk, g_blk = args
        act = jax.nn.gelu(jnp.einsum('td,ted->te', x_blk, u[i_blk], preferred_element_type=jnp.float32))
        return jnp.einsum('te,ted->td', (g_blk * act).astype(v.dtype), v[i_blk])

    return lax.map(block, (xb, ib, gb)).reshape(B, S, D)


def setup_inputs(seed: int = 0) -> dict:
    key = jax.random.key(seed)
    ks = jax.random.split(key, 17)
    n_a = (DEPTH + N_MIXERS - 1) // N_MIXERS
    n_b = DEPTH // N_MIXERS
    f32 = jnp.float32
    nrm = lambda k, shape, scale: jax.random.normal(k, shape, f32) * scale
    gain = lambda k, shape: 1.0 + 0.05 * jax.random.normal(k, shape, f32)
    nq = ATTN_Q_HEADS * ATTN_HEAD_DIM
    f_bias = jnp.linspace(MLSTM_F_BIAS_LO, MLSTM_F_BIAS_HI, MLSTM_HEADS, dtype=f32)
    base = jnp.array([0.0, 1.0, 0.0, 1.0], f32)[:, None] * f_bias[None, :]
    return {
        'x': nrm(ks[0], (BATCH, SEQ, D_MODEL), 1.0),
        'ln_mix': gain(ks[1], (DEPTH, D_MODEL)),
        'ln_ffn': gain(ks[2], (DEPTH, D_MODEL)),
        'mlstm_w_in': nrm(ks[3], (n_a, D_MODEL, MLSTM_IN), D_MODEL ** -0.5),
        'mlstm_gate_bias': base[None] + nrm(ks[4], (n_a, 4, MLSTM_HEADS), 0.1),
        'mlstm_head_norm': gain(ks[5], (n_a, MLSTM_HEADS, MLSTM_V_DIM)),
        'mlstm_w_out': nrm(ks[6], (n_a, MLSTM_HEADS * MLSTM_V_DIM, D_MODEL), (MLSTM_HEADS * MLSTM_V_DIM) ** -0.5),
        'attn_w_in': nrm(ks[7], (n_b, D_MODEL, ATTN_IN), D_MODEL ** -0.5),
        'attn_q_norm': gain(ks[8], (n_b, ATTN_HEAD_DIM)),
        'attn_k_norm': gain(ks[9], (n_b, ATTN_HEAD_DIM)),
        'attn_w_out': nrm(ks[10], (n_b, nq, D_MODEL), nq ** -0.5),
        'peer_wq': nrm(ks[11], (DEPTH, D_MODEL, PEER_HEADS * PEER_QUERY_DIM), D_MODEL ** -0.5),
        'peer_k1': nrm(ks[12], (DEPTH, PEER_N_KEYS, PEER_HALF), PEER_HALF ** -0.5),
        'peer_k2': nrm(ks[13], (DEPTH, PEER_N_KEYS, PEER_HALF), PEER_HALF ** -0.5),
        'peer_u': nrm(ks[14], (DEPTH, PEER_EXPERTS, D_MODEL), D_MODEL ** -0.5),
        'peer_v': nrm(ks[15], (DEPTH, PEER_EXPERTS, D_MODEL), PEER_V_SCALE),
    }


def reference(x, ln_mix, ln_ffn, mlstm_w_in, mlstm_gate_bias, mlstm_head_norm, mlstm_w_out,
              attn_w_in, attn_q_norm, attn_k_norm, attn_w_out,
              peer_wq, peer_k1, peer_k2, peer_u, peer_v):
    for layer in range(DEPTH):
        j = layer // N_MIXERS
        h = rms_norm(x, ln_mix[layer])
        if layer % N_MIXERS == 0:
            x = x + mlstm_mixer(h, mlstm_w_in[j], mlstm_gate_bias[j], mlstm_head_norm[j], mlstm_w_out[j])
        else:
            x = x + attn_mixer(h, attn_w_in[j], attn_q_norm[j], attn_k_norm[j], attn_w_out[j])
        h = rms_norm(x, ln_ffn[layer])
        x = x + peer(h, peer_wq[layer], peer_k1[layer], peer_k2[layer], peer_u[layer], peer_v[layer])
    return x
```

```cpp
#include <hip/hip_runtime.h>
#include <hip/hip_cooperative_groups.h>
#include <cstdio>
#include <cstdint>
namespace cg = cooperative_groups;
namespace pg8 {
#define PG8_LAS __attribute__((address_space(3)))
typedef unsigned short bf16_t;
typedef short bf16x8 __attribute__((ext_vector_type(8)));
typedef float f32x4 __attribute__((ext_vector_type(4)));
typedef unsigned u32x4 __attribute__((ext_vector_type(4)));
constexpr int BM = 256, BK = 64, HALF = 128, HTB = HALF * BK * 2  , STAGE_BYTES = 8 * HTB, NXCD = 8, WGM = 8;

__host__ __device__ __forceinline__ int lds_byte(int r, int c) { const int st = (r >> 4) * 2 + (c >> 5), rr = r & 15, cc = c & 31, ob = rr * 64 + cc * 2; return st * 1024 + (ob ^ (((ob >> 9) & 1) << 5)); }
__host__ __device__ __forceinline__ void stage_rc(int b, int& R, int& C) { const int st = b / 1024, sb = b % 1024, swz = sb ^ (((sb >> 9) & 1) << 5); R = (st >> 1) * 16 + swz / 64; C = (st & 1) * 32 + (swz % 64) / 2; }
__host__ __device__ __forceinline__ int perm32(int rho) { const int n = rho >> 4, i = rho & 15; return 8 * (i >> 2) + 4 * n + (i & 3); }

struct Unit { int pm, pn; };
struct Gemm { const bf16_t* A; const bf16_t* Bt; int M, N, K; };

struct StaticOrder {
    int nM, nN, nwg, G, c;
    __host__ __device__ void init(int M, int N, int G_, int c_) { nM = M / BM; nN = N / BM; nwg = nM * nN; G = G_; c = c_; }
    __host__ __device__ bool next(int i, Unit& u) const {
        const long L = (long)i * G + c; if (L >= nwg) return false;
        int wgid = (int)L; { const int q = nwg / NXCD, r = nwg % NXCD, xcd = wgid % NXCD, off = wgid / NXCD; wgid = (xcd < r ? xcd * (q + 1) : r * (q + 1) + (xcd - r) * q) + off; }
        const int nig = WGM * nN, gid = wgid / nig, fm = gid * WGM, gsz = (nM - fm) < WGM ? (nM - fm) : WGM;
        u.pm = fm + ((wgid % nig) % gsz); u.pn = (wgid % nig) / gsz; return true;
    }
    __device__ __forceinline__ void a_ready(const Unit&) const {}
    __device__ __forceinline__ void done(const Unit&) const {}
};

__device__ __forceinline__ unsigned cvt_pk_bf16(float lo, float hi) { unsigned r; asm volatile("v_cvt_pk_bf16_f32 %0, %1, %2" : "=v"(r) : "v"(lo), "v"(hi)); return r; }
__device__ __forceinline__ float sigmoid_f(float x) { return __builtin_amdgcn_rcpf(1.0f + __expf(-x)); }
struct EpiScaleBf16 {
    static constexpr bool PERM = true, AFTER_DRAIN = false;
    bf16_t* O; int ldc; const float* rs; int sig_from;
    __device__ __forceinline__ void operator()(const f32x4 (&acc)[2][2][4][2], const Unit& u, int wr, int wc, int fr, int fq) const {
        const int row0 = u.pm * BM + wr * 64 + fr; const int col0 = u.pn * BM + wc * 32 + 8 * fq;
        const bool sg = (u.pn * BM) >= sig_from;
#pragma unroll
        for (int ai = 0; ai < 2; ++ai)
#pragma unroll
            for (int m = 0; m < 4; ++m) { const int r = row0 + ai * HALF + m * 16; const float s = rs ? rs[r] : 1.0f; bf16_t* rowp = O + (size_t)r * ldc + col0;
#pragma unroll
                for (int bj = 0; bj < 2; ++bj) { f32x4 v0 = acc[ai][bj][m][0] * s, v1 = acc[ai][bj][m][1] * s;
                    if (sg) { v0 = (f32x4){sigmoid_f(v0[0]), sigmoid_f(v0[1]), sigmoid_f(v0[2]), sigmoid_f(v0[3])}; v1 = (f32x4){sigmoid_f(v1[0]), sigmoid_f(v1[1]), sigmoid_f(v1[2]), sigmoid_f(v1[3])}; }
                    u32x4 w; w.x = cvt_pk_bf16(v0[0], v0[1]); w.y = cvt_pk_bf16(v0[2], v0[3]); w.z = cvt_pk_bf16(v1[0], v1[1]); w.w = cvt_pk_bf16(v1[2], v1[3]);
                    *(u32x4*)(rowp + bj * HALF) = w; } }
    }
};
template <bool BASE_BF, bool F32OUT>
struct EpiResidT {
    static constexpr bool PERM = false, AFTER_DRAIN = false;
    const void* base; float* out; bf16_t* xb; float* part; int ldc;
    __device__ __forceinline__ void operator()(const f32x4 (&acc)[2][2][4][2], const Unit& u, int wr, int wc, int fr, int fq) const {
        typedef unsigned u32x2v __attribute__((ext_vector_type(2)));
        const int row0 = u.pm * BM + wr * 64 + fr; const int col0 = u.pn * BM + wc * 32 + 4 * fq;
#pragma unroll
        for (int ai = 0; ai < 2; ++ai)
#pragma unroll
            for (int m = 0; m < 4; ++m) { const int r = row0 + ai * HALF + m * 16; const size_t off = (size_t)r * ldc + col0; float ss = 0.f;
#pragma unroll
                for (int bj = 0; bj < 2; ++bj)
#pragma unroll
                    for (int n = 0; n < 2; ++n) { f32x4 b;
                        if (BASE_BF) { const u32x2v q = *(const u32x2v*)((const bf16_t*)base + off + bj * HALF + n * 16);
                            b = (f32x4){__uint_as_float(q.x << 16), __uint_as_float(q.x & 0xffff0000u), __uint_as_float(q.y << 16), __uint_as_float(q.y & 0xffff0000u)}; }
                        else b = *(const f32x4*)((const float*)base + off + bj * HALF + n * 16);
                        const f32x4 o = b + acc[ai][bj][m][n];
                        if (F32OUT) *(f32x4*)(out + off + bj * HALF + n * 16) = o;
                        u32x2v w; w.x = cvt_pk_bf16(o[0], o[1]); w.y = cvt_pk_bf16(o[2], o[3]);
                        *(u32x2v*)(xb + off + bj * HALF + n * 16) = w; ss += (o[0] * o[0] + o[1] * o[1]) + (o[2] * o[2] + o[3] * o[3]); }
                ss += __shfl_xor(ss, 16); ss += __shfl_xor(ss, 32);
                if (fq == 0) part[(size_t)r * 32 + u.pn * 4 + wc] = ss;
                if (m & 1) asm volatile("" ::: "memory"); }
    }
};
template <class Epi, class Sched, bool ALIGN_EPI = false, bool SP2 = false>
__device__ __forceinline__ void gemm_phase(PG8_LAS unsigned char* lds, const Gemm g, const Sched& S, const Epi& E) {
    int tid = threadIdx.x; asm volatile("" : "+v"(tid)); const int wid = __builtin_amdgcn_readfirstlane(tid >> 6), lane = tid & 63, wr = wid >> 2, wc = wid & 3, fr = lane & 15, fq = lane >> 4;
    const int K = g.K, nt = K / BK;
    unsigned voffA[2], voffB[2];
#pragma unroll
    for (int i = 0; i < 2; ++i) { int R, C; stage_rc(tid * 16 + i * 8192, R, C); const int Rb = Epi::PERM ? ((R & ~31) + perm32(R & 31)) : R;
        voffA[i] = (unsigned)(R * K + C) * 2u; voffB[i] = (unsigned)(Rb * K + C) * 2u; }
    const size_t kstep = (size_t)(BK * 2);
    const size_t hstep = (size_t)HALF * K * 2;
    const size_t tstep = 2 * hstep;
    const unsigned ldsw = (unsigned)wid * 1024u;
    const int aoff = lds_byte(wr * 64 + fr, fq * 8), boff = lds_byte(wc * 32 + fr, fq * 8);
#define PG8_SA(b, h) (((b) * 2 + (h)) * HTB)
#define PG8_SB(b, h) ((4 + (b) * 2 + (h)) * HTB)
#define PG8_STAGE(bufoff, gbase, voff) do { _Pragma("unroll") for (int _i = 0; _i < 2; ++_i) \
        __builtin_amdgcn_global_load_lds((const unsigned*)((const char*)(gbase) + (voff)[_i]), (PG8_LAS unsigned*)(lds + (bufoff) + ldsw + _i * 8192), 16, 0, 0); } while (0)
#define PG8_LDA(dst, b, h) do { _Pragma("unroll") for (int m = 0; m < 4; ++m) _Pragma("unroll") for (int k = 0; k < 2; ++k) dst[m][k] = *(const PG8_LAS bf16x8*)(lds + PG8_SA(b, h) + aoff + m * 2048 + k * 1024); } while (0)
#define PG8_LDB(dst, b, h) do { _Pragma("unroll") for (int n = 0; n < 2; ++n) _Pragma("unroll") for (int k = 0; k < 2; ++k) dst[n][k] = *(const PG8_LAS bf16x8*)(lds + PG8_SB(b, h) + boff + n * 2048 + k * 1024); } while (0)
#define PG8_MMA(ai, bj, At, Bt) do { __builtin_amdgcn_s_setprio(1); _Pragma("unroll") for (int m = 0; m < 4; ++m) _Pragma("unroll") for (int n = 0; n < 2; ++n) _Pragma("unroll") for (int k = 0; k < 2; ++k) \
        acc[ai][bj][m][n] = __builtin_amdgcn_mfma_f32_16x16x32_bf16(Bt[n][k], At[m][k], acc[ai][bj][m][n], 0, 0, 0); __builtin_amdgcn_s_setprio(0); } while (0)
#define PG8_WAIT_V(n) asm volatile("s_waitcnt vmcnt(" #n ")" ::: "memory")
#define PG8_WAIT_L(n) asm volatile("s_waitcnt lgkmcnt(" #n ")" ::: "memory")
#define PG8_BAR __builtin_amdgcn_s_barrier()
#define PG8_SCHED __builtin_amdgcn_sched_barrier(0)
    Unit cur, nxt; int ui = 0;
    if (!S.next(0, cur)) return;
    f32x4 acc[2][2][4][2];
#pragma unroll
    for (int a = 0; a < 2; ++a)
#pragma unroll
        for (int b = 0; b < 2; ++b)
#pragma unroll
            for (int m = 0; m < 4; ++m)
#pragma unroll
                for (int n = 0; n < 2; ++n) acc[a][b][m][n] = (f32x4){0.f, 0.f, 0.f, 0.f};
    bf16x8 At[4][2], B0[2][2], B1[2][2];
    const char* cA = (const char*)g.A + (size_t)cur.pm * tstep; const char* cB = (const char*)g.Bt + (size_t)cur.pn * tstep;
    S.a_ready(cur);
    if constexpr (SP2) {
        PG8_STAGE(PG8_SB(0, 0), cB, voffB); PG8_STAGE(PG8_SB(0, 1), cB + hstep, voffB); PG8_STAGE(PG8_SA(0, 0), cA, voffA); PG8_STAGE(PG8_SA(0, 1), cA + hstep, voffA);
        if (wr == 1) PG8_BAR;
        PG8_WAIT_V(2); PG8_BAR;
        PG8_STAGE(PG8_SB(1, 0), cB + kstep, voffB); PG8_STAGE(PG8_SA(1, 0), cA + kstep, voffA); PG8_STAGE(PG8_SB(1, 1), cB + hstep + kstep, voffB);
        PG8_WAIT_V(6); PG8_BAR;
    } else {
        PG8_STAGE(PG8_SB(0, 0), cB, voffB); PG8_STAGE(PG8_SA(0, 0), cA, voffA); PG8_STAGE(PG8_SB(0, 1), cB + hstep, voffB); PG8_STAGE(PG8_SA(0, 1), cA + hstep, voffA);
        if (wr == 1) PG8_BAR;
        PG8_WAIT_V(4); PG8_BAR;
        PG8_STAGE(PG8_SB(1, 0), cB + kstep, voffB); PG8_STAGE(PG8_SA(1, 0), cA + kstep, voffA); PG8_STAGE(PG8_SB(1, 1), cB + hstep + kstep, voffB);
        PG8_WAIT_V(6); PG8_BAR;
    }
    for (;;) {
        const bool has_next = S.next(ui + 1, nxt);
        const char* nA = has_next ? (const char*)g.A + (size_t)nxt.pm * tstep : cA; const char* nB = has_next ? (const char*)g.Bt + (size_t)nxt.pn * tstep : cB;
        for (int t = 0; t < nt; t += 2) {
            const bool last = (t == nt - 2);
            const char* a1 = cA + (size_t)(t + 1) * kstep;
            const char* a2 = last ? nA : cA + (size_t)(t + 2) * kstep; const char* b2 = last ? nB : cB + (size_t)(t + 2) * kstep;
            const char* a3 = a2 + kstep; const char* b3 = b2 + kstep;
            if (last && has_next) S.a_ready(nxt);
            if constexpr (SP2) {
            PG8_LDB(B0, 0, 0); PG8_LDB(B1, 0, 1); PG8_SCHED; PG8_LDA(At, 0, 0); PG8_STAGE(PG8_SA(1, 1), a1 + hstep, voffA);
            PG8_WAIT_V(8); PG8_WAIT_L(0); PG8_BAR; PG8_MMA(0, 0, At, B0); PG8_MMA(0, 1, At, B1); PG8_BAR; PG8_SCHED;
            PG8_LDA(At, 0, 1); PG8_STAGE(PG8_SB(0, 0), b2, voffB); PG8_STAGE(PG8_SB(0, 1), b2 + hstep, voffB); PG8_STAGE(PG8_SA(0, 0), a2, voffA);
            PG8_WAIT_V(8); PG8_WAIT_L(0); PG8_BAR; PG8_MMA(1, 0, At, B0); PG8_MMA(1, 1, At, B1); PG8_BAR; PG8_SCHED;
            PG8_LDB(B0, 1, 0); PG8_LDB(B1, 1, 1); PG8_SCHED; PG8_LDA(At, 1, 0); PG8_STAGE(PG8_SA(0, 1), a2 + hstep, voffA);
            PG8_WAIT_V(8); PG8_WAIT_L(0); PG8_BAR; PG8_MMA(0, 0, At, B0); PG8_MMA(0, 1, At, B1); PG8_BAR; PG8_SCHED;
            PG8_LDA(At, 1, 1); PG8_STAGE(PG8_SB(1, 0), b3, voffB); PG8_STAGE(PG8_SB(1, 1), b3 + hstep, voffB); PG8_STAGE(PG8_SA(1, 0), a3, voffA);
            PG8_WAIT_V(8); PG8_WAIT_L(0); PG8_BAR; PG8_MMA(1, 0, At, B0); PG8_MMA(1, 1, At, B1); PG8_BAR; PG8_SCHED;
            } else {
            PG8_LDB(B0, 0, 0); PG8_SCHED; PG8_LDA(At, 0, 0); PG8_STAGE(PG8_SA(1, 1), a1 + hstep, voffA);
            PG8_WAIT_L(8); PG8_BAR; PG8_WAIT_L(0); PG8_MMA(0, 0, At, B0); PG8_BAR; PG8_SCHED;
            PG8_LDB(B1, 0, 1); PG8_STAGE(PG8_SB(0, 0), b2, voffB);
            PG8_BAR; PG8_WAIT_L(0); PG8_MMA(0, 1, At, B1); PG8_BAR;
            PG8_LDA(At, 0, 1); PG8_STAGE(PG8_SA(0, 0), a2, voffA);
            PG8_BAR; PG8_WAIT_L(0); PG8_MMA(1, 0, At, B0); PG8_BAR; PG8_SCHED;
            PG8_STAGE(PG8_SB(0, 1), b2 + hstep, voffB);
            PG8_WAIT_V(6); PG8_BAR; PG8_MMA(1, 1, At, B1); PG8_BAR;
            PG8_LDB(B0, 1, 0); PG8_SCHED; PG8_LDA(At, 1, 0); PG8_STAGE(PG8_SA(0, 1), a2 + hstep, voffA);
            PG8_WAIT_L(8); PG8_BAR; PG8_WAIT_L(0); PG8_MMA(0, 0, At, B0); PG8_BAR; PG8_SCHED;
            PG8_LDB(B1, 1, 1); PG8_STAGE(PG8_SB(1, 0), b3, voffB);
            PG8_BAR; PG8_WAIT_L(0); PG8_MMA(0, 1, At, B1); PG8_BAR;
            PG8_LDA(At, 1, 1); PG8_STAGE(PG8_SA(1, 0), a3, voffA);
            PG8_BAR; PG8_WAIT_L(0); PG8_MMA(1, 0, At, B0); PG8_BAR; PG8_SCHED;
            PG8_STAGE(PG8_SB(1, 1), b3 + hstep, voffB);
            PG8_WAIT_V(6); PG8_BAR; PG8_MMA(1, 1, At, B1); PG8_BAR;
            }
        }
        if constexpr (ALIGN_EPI) { if (wr == 0) PG8_BAR; }
        if constexpr (!Epi::AFTER_DRAIN) { E(acc, cur, wr, wc, fr, fq); S.done(cur); }
        if (!has_next) break;
#pragma unroll
        for (int a = 0; a < 2; ++a)
#pragma unroll
            for (int b = 0; b < 2; ++b)
#pragma unroll
                for (int m = 0; m < 4; ++m)
#pragma unroll
                    for (int n = 0; n < 2; ++n) acc[a][b][m][n] = (f32x4){0.f, 0.f, 0.f, 0.f};
        cur = nxt; cA = nA; cB = nB; ++ui;
        if constexpr (ALIGN_EPI) { if (wr == 1) PG8_BAR; }
    }
    PG8_WAIT_V(0);
    if constexpr (!ALIGN_EPI) { if (wr == 0) PG8_BAR; }
    PG8_BAR;
    if constexpr (Epi::AFTER_DRAIN) { E.fused(acc, cur, wr, wc, fr, fq, lds, wid, lane); S.done(cur); }
#undef PG8_SA
#undef PG8_SB
#undef PG8_STAGE
#undef PG8_LDA
#undef PG8_LDB
#undef PG8_MMA
#undef PG8_WAIT_V
#undef PG8_WAIT_L
#undef PG8_BAR
#undef PG8_SCHED
}
}

#ifndef PG8_SP2
#define PG8_SP2 true
#endif
#ifndef PG8_ALIGN
#define PG8_ALIGN true
#endif
constexpr int NWAVES = 8, NTHREADS = 512;
constexpr int BATCH = 8, SEQ = 2048, DM = 2048, TOK = BATCH * SEQ;
constexpr float NORM_EPS = 1e-6f;
constexpr int MH = 4, MDK = 256, MDV = 512, MLSTM_IN = 6160, MPROJ = 6144;
constexpr int AHQ = 16, AHKV = 4, AD = 128, APROJ = 3072;
constexpr float PEER_U4_SCALE = 90.50966799f;
constexpr float PEER_U_SCALE = 2048.0f, PEER_V_SCALE = 128.0f, PEER_W_SCALE = 64.0f;
constexpr int PHEADS = 8, PKEYS = 128, PTOPK = 16, PHALF = 128, PEXP = 16384, PE = PHEADS * PTOPK;
constexpr size_t MiB = 1u << 20;
constexpr size_t WS_CTL = 0, CTL_ZERO_BYTES = 1 * MiB;
constexpr size_t WS_WIN  = 2 * MiB;
constexpr size_t WS_WOUT = 26 * MiB;
constexpr size_t WS_AIN  = 34 * MiB;
constexpr size_t WS_AOUT = 46 * MiB;
constexpr size_t WS_WQ   = 54 * MiB;
constexpr size_t WS_PK   = 70 * MiB;
constexpr size_t WS_ROPE = 71 * MiB;
constexpr size_t WS_GATE = 72 * MiB;
constexpr size_t WS_SC   = 73 * MiB;
constexpr size_t WS_RSTD = 75 * MiB;
constexpr size_t WS_PART = 76 * MiB;
constexpr size_t WS_IDX  = 78 * MiB;
constexpr size_t WS_GSM  = 86 * MiB;
constexpr size_t WS_XB0  = 96 * MiB;
constexpr size_t WS_XB1  = 160 * MiB;
constexpr size_t WS_XR   = 224 * MiB;
constexpr size_t WS_PROJ = 352 * MiB;
constexpr size_t WS_HS   = 544 * MiB;
constexpr size_t WS_HB   = 608 * MiB;
constexpr size_t WS_UB   = 672 * MiB;
constexpr size_t WS_VB   = 736 * MiB;
constexpr size_t WS_PSCR = 800 * MiB;
constexpr size_t WS_END  = 928 * MiB;
constexpr int CW_BAR = 4096, CW_RANK = 8192;
constexpr int RING_BYTES = 159744;
constexpr int LDSCTL_OFF = RING_BYTES, MISC_OFF = LDSCTL_OFF + 320;
constexpr int LDS_BYTES = 163840;
#define GAS __attribute__((address_space(1)))
#define LAS __attribute__((address_space(3)))
typedef unsigned short bf16;
typedef unsigned gu32;
typedef float f32x4 __attribute__((ext_vector_type(4)));
typedef float f32x2 __attribute__((ext_vector_type(2)));
typedef float f32x16 __attribute__((ext_vector_type(16)));
typedef unsigned u32x4 __attribute__((ext_vector_type(4)));
typedef unsigned u32x2 __attribute__((ext_vector_type(2)));
typedef short bf16x8 __attribute__((ext_vector_type(8)));
typedef short s16x4 __attribute__((ext_vector_type(4)));
#define RLX_AGENT __ATOMIC_RELAXED, __HIP_MEMORY_SCOPE_AGENT
#define LDS_WAIT() asm volatile("s_waitcnt lgkmcnt(0)" ::: "memory")
#define VM_WAIT() asm volatile("s_waitcnt vmcnt(0)" ::: "memory")
#define SBAR() __builtin_amdgcn_sched_barrier(0)
__device__ __forceinline__ unsigned cvtpk(float lo, float hi) { unsigned r; asm volatile("v_cvt_pk_bf16_f32 %0, %1, %2" : "=v"(r) : "v"(lo), "v"(hi)); return r; }
__device__ __forceinline__ float bf_lo(unsigned w) { return __uint_as_float(w << 16); }
__device__ __forceinline__ float bf_hi(unsigned w) { return __uint_as_float(w & 0xffff0000u); }
__device__ __forceinline__ int opaque_tid() { int t = threadIdx.x; asm volatile("" : "+v"(t)); return t; }
__device__ __forceinline__ void assume_global(const void* p) {
#if defined(__HIP_DEVICE_COMPILE__)
    __builtin_assume(!__builtin_amdgcn_is_shared((const __attribute__((address_space(0))) void*)p) && !__builtin_amdgcn_is_private((const __attribute__((address_space(0))) void*)p));
#endif
}
__device__ __forceinline__ float wave_sum(float v) {
#pragma unroll
    for (int o = 1; o < 64; o <<= 1) v += __shfl_xor(v, o);
    return v;
}
#define XB_TMO      128
#define XB_XCNT(j)  (256  + 64 * (j))
#define XB_XSUB(j)  (1280 + 64 * (j))
#define XB_XGEN(j)  (2304 + 64 * (j))
#define XB_TOP      3328
#define XB_TOPGEN   3392
#define XCD_BAR_WORDS 3456
#define XB_SPIN_CAP (1u << 20)
__device__ __forceinline__ unsigned xb_ld(unsigned* p)              { return __hip_atomic_load(p, __ATOMIC_RELAXED, __HIP_MEMORY_SCOPE_AGENT); }
__device__ __forceinline__ unsigned xb_add(unsigned* p, unsigned v) { return __hip_atomic_fetch_add(p, v, __ATOMIC_RELAXED, __HIP_MEMORY_SCOPE_AGENT); }
__device__ __forceinline__ unsigned xb_xcc_id() { return (unsigned)__builtin_amdgcn_s_getreg((3 << 11) | 20) & 0xFu; }
#define XB_SPIN(cond, bar) do { unsigned _sp = 0; while (cond) { __builtin_amdgcn_s_sleep(1); \
    if ((++_sp & 255u) == 0u) { if (xb_ld(&(bar)[XB_TMO])) break; if (_sp > XB_SPIN_CAP) { atomicAdd(&(bar)[XB_TMO], 1u); break; } } } } while (0)
struct XcdBarrier { unsigned* bar; unsigned x; volatile LAS unsigned* st; };
__device__ __forceinline__ XcdBarrier xcd_barrier_post(unsigned* bar, volatile LAS unsigned* st) {
    XcdBarrier b; b.bar = bar; b.x = xb_xcc_id(); b.st = st;
    if (threadIdx.x == 0) (void)xb_add(&bar[XB_XCNT(b.x)], 1u);
    return b;
}
__device__ __forceinline__ void xcd_barrier_complete(unsigned* bar, unsigned x, unsigned& nloc, unsigned& nx) {
    const unsigned G = gridDim.x * gridDim.y * gridDim.z;
    unsigned sum, cnt, mine, sp = 0u;
    for (;;) {
        sum = 0u; cnt = 0u; mine = 0u;
#pragma unroll
        for (unsigned j = 0; j < 16; ++j) { const unsigned c = xb_ld(&bar[XB_XCNT(j)]); sum += c; cnt += (c > 0u) ? 1u : 0u; mine = (j == x) ? c : mine; }
        if (sum == G) break;
        __builtin_amdgcn_s_sleep(1);
        if ((++sp & 255u) == 0u) { if (xb_ld(&bar[XB_TMO])) break; if (sp > XB_SPIN_CAP) { atomicAdd(&bar[XB_TMO], 1u); break; } }
    }
    nloc = mine > 0u ? mine : 1u; nx = cnt > 0u ? cnt : 1u;
}
__device__ __forceinline__ void xcd_barrier(const XcdBarrier& b) {
    asm volatile("s_waitcnt vmcnt(0)" ::: "memory");
    __syncthreads();
    if (threadIdx.x == 0) {
        unsigned* bar = b.bar;
        __builtin_amdgcn_s_waitcnt(0);
        unsigned nloc = b.st[0], nx = b.st[1];
        if (nloc == 0u) { xcd_barrier_complete(bar, b.x, nloc, nx); b.st[0] = nloc; b.st[1] = nx; }
        const unsigned old = xb_add(&bar[XB_XSUB(b.x)], 1u);
        const unsigned gen = old / nloc;
        if (old + 1u == (gen + 1u) * nloc) {
            __builtin_amdgcn_fence(__ATOMIC_RELEASE, "agent");
            asm volatile("s_waitcnt vmcnt(0)" ::: "memory");
            const unsigned og = xb_add(&bar[XB_TOP], 1u);
            const unsigned tg = og / nx;
            if (og + 1u == (tg + 1u) * nx) xb_add(&bar[XB_TOPGEN], 1u);
            else XB_SPIN(xb_ld(&bar[XB_TOPGEN]) == tg, bar);
            __builtin_amdgcn_fence(__ATOMIC_ACQUIRE, "agent");
            asm volatile("s_waitcnt vmcnt(0)" ::: "memory");
        } else {
            XB_SPIN(xb_ld(&bar[XB_TOPGEN]) == gen, bar);
            __builtin_amdgcn_fence(__ATOMIC_ACQUIRE, "agent");
            asm volatile("s_waitcnt vmcnt(0)" ::: "memory");
        }
    }
    __syncthreads();
}
struct Frame {
    LAS unsigned char* lds;
    volatile LAS unsigned* MISC;
    gu32* ctl;
    int tid, lane, wave, G;
    GAS unsigned char* ws;
    const GAS float* in[16];
    GAS float* out;
};
__device__ __forceinline__ unsigned f2bf(float f) { unsigned u = __builtin_bit_cast(unsigned, f); return (u + 0x7fffu + ((u >> 16) & 1u)) >> 16; }
__device__ __forceinline__ unsigned pk2(float lo, float hi) { return f2bf(lo) | (f2bf(hi) << 16); }
__device__ __forceinline__ void p0_transpose_item(const float* W, int ldw, int K, int ncols, bf16* WT, const float* gain, int qrows, LAS float* scr, int item, int lane) {
    const int nblk = ncols / 32, kb = item / nblk, nb = item % nblk, k0 = 64 * kb, n0 = 32 * nb;
    const float sc = (n0 < qrows) ? 0.0625f : 1.0f;
    const int c = lane & 7;
    float wv[32];
#pragma unroll
    for (int i = 0; i < 32; ++i) wv[i] = W[(size_t)(k0 + 2 * i + (lane >> 5)) * ldw + n0 + (lane & 31)];
    f32x4 ga = {sc, sc, sc, sc}, gb = ga;
    if (gain) { ga = *(const f32x4*)(gain + k0 + 8 * c) * sc; gb = *(const f32x4*)(gain + k0 + 8 * c + 4) * sc; }
#pragma unroll
    for (int i = 0; i < 32; ++i) { const int kk = 2 * i + (lane >> 5); scr[kk * 33 + (lane & 31)] = wv[i]; }
    LDS_WAIT(); asm volatile("" ::: "memory");
#pragma unroll
    for (int j = 0; j < 4; ++j) { const int n = (lane >> 3) + 8 * j; const LAS float* s = scr + (8 * c) * 33 + n;
        u32x4 o; o.x = pk2(s[0 * 33] * ga[0], s[1 * 33] * ga[1]); o.y = pk2(s[2 * 33] * ga[2], s[3 * 33] * ga[3]); o.z = pk2(s[4 * 33] * gb[0], s[5 * 33] * gb[1]); o.w = pk2(s[6 * 33] * gb[2], s[7 * 33] * gb[3]);
        *(u32x4*)(WT + (size_t)(n0 + n) * K + k0 + 8 * c) = o; }
    LDS_WAIT(); asm volatile("" ::: "memory");
}
__device__ __forceinline__ void p0_convert(const float* src, bf16* dst, size_t n8, const float* gain, size_t gtid, size_t gthreads) {
    for (size_t i = gtid; i < n8; i += gthreads) {
        const f32x4 a = *(const f32x4*)(src + i * 8), b = *(const f32x4*)(src + i * 8 + 4);
        f32x4 ga = {1.f, 1.f, 1.f, 1.f}, gb = ga;
        if (gain) { const int c = (int)((i * 8) & 2047); ga = *(const f32x4*)(gain + c); gb = *(const f32x4*)(gain + c + 4); }
        u32x4 o; o.x = cvtpk(a[0] * ga[0], a[1] * ga[1]); o.y = cvtpk(a[2] * ga[2], a[3] * ga[3]); o.z = cvtpk(b[0] * gb[0], b[1] * gb[1]); o.w = cvtpk(b[2] * gb[2], b[3] * gb[3]);
        *(u32x4*)(dst + i * 8) = o;
    }
}
__device__ __forceinline__ void p0_convert_sliced_fp4(const float* src, unsigned char* dst, const float* gain, float scale, size_t gtid, size_t gthreads) {
    const size_t n32 = (size_t)PEXP * DM / 32;
#pragma unroll 2
    for (size_t i = gtid; i < n32; i += gthreads) {
        const int c32 = (int)(i & 63); const size_t e = i >> 6;
        u32x4 o;
#pragma unroll
        for (int q = 0; q < 4; ++q) {
            f32x4 a0 = *(const f32x4*)(src + i * 32 + q * 8), a1 = *(const f32x4*)(src + i * 32 + q * 8 + 4);
            if (gain) { a0 = a0 * *(const f32x4*)(gain + c32 * 32 + q * 8); a1 = a1 * *(const f32x4*)(gain + c32 * 32 + q * 8 + 4); }
            a0 = a0 * scale; a1 = a1 * scale;
#pragma unroll
            for (int k = 0; k < 4; ++k) { a0[k] = __builtin_amdgcn_fmed3f(a0[k], -6.f, 6.f); a1[k] = __builtin_amdgcn_fmed3f(a1[k], -6.f, 6.f); }
            unsigned p4 = 0;
            p4 = __builtin_amdgcn_cvt_scalef32_pk_fp4_f32(p4, a0[0], a0[1], 1.0f, 0); p4 = __builtin_amdgcn_cvt_scalef32_pk_fp4_f32(p4, a0[2], a0[3], 1.0f, 1);
            p4 = __builtin_amdgcn_cvt_scalef32_pk_fp4_f32(p4, a1[0], a1[1], 1.0f, 2); p4 = __builtin_amdgcn_cvt_scalef32_pk_fp4_f32(p4, a1[2], a1[3], 1.0f, 3);
            o[q] = p4;
        }
        *(u32x4*)(dst + (((size_t)(c32 >> 3) * PEXP + e) * 8 + (c32 & 7)) * 16) = o;
    }
}
__device__ __forceinline__ void p0_convert_sliced_fp4v(const float* src, unsigned char* dst, float scale, size_t gtid, size_t gthreads) {
    const size_t n64 = (size_t)PEXP * DM / 64;
#pragma unroll 1
    for (size_t i = gtid; i < n64; i += gthreads) {
        const int w64 = (int)(i & 31); const size_t e = i >> 5;
        f32x4 a[16];
#pragma unroll
        for (int n = 0; n < 16; ++n) { a[n] = *(const f32x4*)(src + i * 64 + n * 4) * scale;
#pragma unroll
            for (int k = 0; k < 4; ++k) a[n][k] = __builtin_amdgcn_fmed3f(a[n][k], -6.f, 6.f); }
        u32x4 o0, o1;
#pragma unroll
        for (int d = 0; d < 4; ++d) {
            const int k = d >> 1, nb = 8 * (d & 1);
            unsigned p0 = 0, p1 = 0;
            p0 = __builtin_amdgcn_cvt_scalef32_pk_fp4_f32(p0, a[nb + 0][k], a[nb + 1][k], 1.0f, 0); p0 = __builtin_amdgcn_cvt_scalef32_pk_fp4_f32(p0, a[nb + 2][k], a[nb + 3][k], 1.0f, 1);
            p0 = __builtin_amdgcn_cvt_scalef32_pk_fp4_f32(p0, a[nb + 4][k], a[nb + 5][k], 1.0f, 2); p0 = __builtin_amdgcn_cvt_scalef32_pk_fp4_f32(p0, a[nb + 6][k], a[nb + 7][k], 1.0f, 3);
            p1 = __builtin_amdgcn_cvt_scalef32_pk_fp4_f32(p1, a[nb + 0][k + 2], a[nb + 1][k + 2], 1.0f, 0); p1 = __builtin_amdgcn_cvt_scalef32_pk_fp4_f32(p1, a[nb + 2][k + 2], a[nb + 3][k + 2], 1.0f, 1);
            p1 = __builtin_amdgcn_cvt_scalef32_pk_fp4_f32(p1, a[nb + 4][k + 2], a[nb + 5][k + 2], 1.0f, 2); p1 = __builtin_amdgcn_cvt_scalef32_pk_fp4_f32(p1, a[nb + 6][k + 2], a[nb + 7][k + 2], 1.0f, 3);
            o0[d] = p0; o1[d] = p1;
        }
        unsigned char* piece = dst + ((size_t)(w64 >> 2) * PEXP + e) * 128;
        *(u32x4*)(piece + (w64 & 3) * 16) = o0; *(u32x4*)(piece + ((w64 & 3) + 4) * 16) = o1;
    }
}
__device__ __forceinline__ void p0_prologue(Frame& F) {
    const float* x = (const float*)F.in[0]; const float* ln_mix = (const float*)F.in[1]; const float* ln_ffn = (const float*)F.in[2]; const float* w_in = (const float*)F.in[3]; const float* gate_bias = (const float*)F.in[4];
    const float* w_out = (const float*)F.in[6]; const float* a_in = (const float*)F.in[7]; const float* a_out = (const float*)F.in[10]; const float* wq = (const float*)F.in[11];
    const float* k1 = (const float*)F.in[12]; const float* k2 = (const float*)F.in[13]; const float* pu = (const float*)F.in[14]; const float* pv = (const float*)F.in[15];
    GAS unsigned char* ws = F.ws;
    const int gw = blockIdx.x * NWAVES + F.wave, NGW = F.G * NWAVES;
    const size_t gtid = (size_t)blockIdx.x * NTHREADS + F.tid, gthreads = (size_t)F.G * NTHREADS;
#ifndef REP_P0
#define REP_P0 0
#endif
    for (int rp_ = 0; rp_ < 1 + (REP_P0 & 1); ++rp_) {
        LAS float* scr = (LAS float*)(F.lds + F.wave * 16384);
        constexpr int I_IN = (DM / 64) * (MPROJ / 32), I_SQ = (DM / 64) * (DM / 32), I_AIN = (DM / 64) * (APROJ / 32);
        constexpr int NITEMS = I_IN + I_SQ + I_AIN + I_SQ + 2 * I_SQ;
        for (int it = gw; it < NITEMS; it += NGW) {
            int r = it;
            if (r < I_IN) { p0_transpose_item(w_in, MLSTM_IN, DM, MPROJ, (bf16*)(ws + WS_WIN), ln_mix, 1024, scr, r, F.lane); continue; } r -= I_IN;
            if (r < I_SQ) { p0_transpose_item(w_out, DM, DM, DM, (bf16*)(ws + WS_WOUT), nullptr, 0, scr, r, F.lane); continue; } r -= I_SQ;
            if (r < I_AIN) { p0_transpose_item(a_in, APROJ, DM, APROJ, (bf16*)(ws + WS_AIN), ln_mix + DM, 0, scr, r, F.lane); continue; } r -= I_AIN;
            if (r < I_SQ) { p0_transpose_item(a_out, DM, DM, DM, (bf16*)(ws + WS_AOUT), nullptr, 0, scr, r, F.lane); continue; } r -= I_SQ;
            if (r < I_SQ) { p0_transpose_item(wq, DM, DM, DM, (bf16*)(ws + WS_WQ), ln_ffn, 0, scr, r, F.lane); continue; } r -= I_SQ;
            p0_transpose_item(wq + (size_t)DM * DM, DM, DM, DM, (bf16*)(ws + WS_WQ) + (size_t)DM * DM, ln_ffn + DM, 0, scr, r, F.lane);
        }
    }
    for (int rp_ = 0; rp_ < 1 + ((REP_P0 >> 1) & 1); ++rp_) {
        for (int l = 0; l < 2; ++l) {
            p0_convert_sliced_fp4(pu + (size_t)l * PEXP * DM, (unsigned char*)(ws + WS_UB) + (size_t)l * PEXP * (DM / 2), ln_ffn + l * DM, PEER_U4_SCALE, gtid, gthreads);
            p0_convert_sliced_fp4v(pv + (size_t)l * PEXP * DM, (unsigned char*)(ws + WS_VB) + (size_t)l * PEXP * (DM / 2), 5.656854249f, gtid, gthreads);
            p0_convert(k1 + (size_t)l * PKEYS * PHALF, (bf16*)(ws + WS_PK) + (size_t)(l * 2 + 0) * PKEYS * PHALF, (size_t)PKEYS * PHALF / 8, nullptr, gtid, gthreads);
            p0_convert(k2 + (size_t)l * PKEYS * PHALF, (bf16*)(ws + WS_PK) + (size_t)(l * 2 + 1) * PKEYS * PHALF, (size_t)PKEYS * PHALF / 8, nullptr, gtid, gthreads);
        }
        float* cosT = (float*)(ws + WS_ROPE); float* sinT = cosT + SEQ * 64;
        for (size_t i = gtid; i < (size_t)SEQ * 64; i += gthreads) {
            const int t = (int)(i >> 6), j = (int)(i & 63);
            const float freq = powf(10000.0f, -(float)(j & 31) / 32.0f);
            const float pos = (j < 32) ? (float)(t >> 6) : (float)(t & 63);
            const float ang = pos * freq;
            cosT[i] = cosf(ang); sinT[i] = sinf(ang);
        }
    }
    __syncthreads();
    for (int rp_ = 0; rp_ < 1 + ((REP_P0 >> 2) & 1); ++rp_) {
        __syncthreads();
        LAS float* Wg = (LAS float*)F.lds;
        for (int i = F.tid; i < 16 * DM; i += NTHREADS) { const int k = i >> 4, g = i & 15; Wg[g * DM + k] = w_in[(size_t)k * MLSTM_IN + MPROJ + g] * ln_mix[k]; }
        __syncthreads();
        float* rstd0 = (float*)(ws + WS_RSTD); float* gates = (float*)(ws + WS_GATE); bf16* xb = (bf16*)(ws + WS_XB0);
        f32x4 vn[8];
        if (gw < TOK) { const f32x4* xr0 = (const f32x4*)(x + (size_t)gw * DM) + F.lane;
#pragma unroll
            for (int j = 0; j < 8; ++j) vn[j] = xr0[64 * j]; }
        for (int m = gw; m < TOK; m += NGW) {
            f32x4 v[8]; float ss = 0.f;
#pragma unroll
            for (int j = 0; j < 8; ++j) { v[j] = vn[j]; ss += (v[j][0] * v[j][0] + v[j][1] * v[j][1]) + (v[j][2] * v[j][2] + v[j][3] * v[j][3]); }
            { const int mn = (m + NGW < TOK) ? m + NGW : m; const f32x4* xrn = (const f32x4*)(x + (size_t)mn * DM) + F.lane;
#pragma unroll
              for (int j = 0; j < 8; ++j) vn[j] = xrn[64 * j]; }
            const float rstd = 1.0f / sqrtf(wave_sum(ss) * (1.0f / DM) + NORM_EPS);
            u32x2* o8 = (u32x2*)(xb + (size_t)m * DM) + F.lane;
#pragma unroll
            for (int j = 0; j < 8; ++j) { u32x2 w; w.x = cvtpk(v[j][0], v[j][1]); w.y = cvtpk(v[j][2], v[j][3]); o8[64 * j] = w; }
            float mine = 0.f;
#pragma unroll
            for (int g = 0; g < 16; ++g) {
                float s = 0.f;
#pragma unroll
                for (int j = 0; j < 8; ++j) { const f32x4 w = *(const LAS f32x4*)(Wg + g * DM + 256 * j + 4 * F.lane); s += (v[j][0] * w[0] + v[j][1] * w[1]) + (v[j][2] * w[2] + v[j][3] * w[3]); }
                s = wave_sum(s);
                if (F.lane == g) mine = s;
            }
            if (F.lane < 16) gates[(size_t)m * 16 + F.lane] = mine * rstd + gate_bias[F.lane];
            if (F.lane == 0) rstd0[m] = rstd;
        }
    }
    __syncthreads();
}
__device__ __forceinline__ int crow(int r, int hi) { return (r & 3) + 8 * (r >> 2) + 4 * hi; }
template <int ND0, int ROWB>
__device__ __forceinline__ void qkt(f32x16& p0, f32x16& p1, const char* Ks, const bf16x8* qr, int r32, int hi) {
    p0 = f32x16{}; p1 = f32x16{};
    int sw = (r32 & 7) << 4;
    asm volatile("" : "+v"(sw));
#pragma unroll
    for (int d0 = 0; d0 < ND0; ++d0) { const int cb = (d0 * 16 + hi * 8) * 2;
        const bf16x8 b0 = *reinterpret_cast<const bf16x8*>(Ks + r32 * ROWB + (cb ^ sw));
        const bf16x8 b1 = *reinterpret_cast<const bf16x8*>(Ks + (32 + r32) * ROWB + (cb ^ sw));
        p0 = __builtin_amdgcn_mfma_f32_32x32x16_bf16(b0, qr[d0], p0, 0, 0, 0);
        p1 = __builtin_amdgcn_mfma_f32_32x32x16_bf16(b1, qr[d0], p1, 0, 0, 0); }
}
__device__ __forceinline__ int v_st(int k, int c) { const int kk = (k & ~0xC) | ((k & 4) << 1) | ((k & 8) >> 1); return ((kk >> 3) * 4 + (c >> 5)) * 512 + ((kk & 7) * 32 + (c & 31)) * 2; }
__device__ __forceinline__ int v_rd_base(int lane) { return ((lane & 3) << 3) | (((lane >> 2) & 3) << 6) | (((lane >> 4) & 1) << 5) | (((lane >> 5) & 1) << 8); }
constexpr int v_rd_off(int d0, int ks, int half) { return d0 * 512 + ks * 4096 + half * 2048; }
template <int OFF> __device__ __forceinline__ s16x4 tr_read(int vb) {
    s16x4 r; asm volatile("ds_read_b64_tr_b16 %0, %1 offset:%2" : "=&v"(r) : "v"(vb), "i"(OFF) : "memory"); return r;
}
template <int D0> __device__ __forceinline__ void pv_one(f32x16& od, int vb, bf16x8 pa0, bf16x8 pa1, bf16x8 pa2, bf16x8 pa3) {
    const s16x4 l0 = tr_read<v_rd_off(D0, 0, 0)>(vb), h0 = tr_read<v_rd_off(D0, 0, 1)>(vb), l1 = tr_read<v_rd_off(D0, 1, 0)>(vb), h1 = tr_read<v_rd_off(D0, 1, 1)>(vb);
    const s16x4 l2 = tr_read<v_rd_off(D0, 2, 0)>(vb), h2 = tr_read<v_rd_off(D0, 2, 1)>(vb), l3 = tr_read<v_rd_off(D0, 3, 0)>(vb), h3 = tr_read<v_rd_off(D0, 3, 1)>(vb);
    asm volatile("s_waitcnt lgkmcnt(0)" ::: "memory"); SBAR();
#define PKV(L, H) (bf16x8){L[0], L[1], L[2], L[3], H[0], H[1], H[2], H[3]}
    od = __builtin_amdgcn_mfma_f32_32x32x16_bf16(pa0, PKV(l0, h0), od, 0, 0, 0);
    od = __builtin_amdgcn_mfma_f32_32x32x16_bf16(pa1, PKV(l1, h1), od, 0, 0, 0);
    od = __builtin_amdgcn_mfma_f32_32x32x16_bf16(pa2, PKV(l2, h2), od, 0, 0, 0);
    od = __builtin_amdgcn_mfma_f32_32x32x16_bf16(pa3, PKV(l3, h3), od, 0, 0, 0);
#undef PKV
}
__device__ __forceinline__ void pv_d0(f32x16* o, int vb, bf16x8 pa0, bf16x8 pa1, bf16x8 pa2, bf16x8 pa3) {
    pv_one<0>(o[0], vb, pa0, pa1, pa2, pa3); pv_one<1>(o[1], vb, pa0, pa1, pa2, pa3); pv_one<2>(o[2], vb, pa0, pa1, pa2, pa3); pv_one<3>(o[3], vb, pa0, pa1, pa2, pa3);
}
#define PK4(P, BASE, OUT) do { unsigned a0_ = cvtpk(P[BASE + 0], P[BASE + 1]), a1_ = cvtpk(P[BASE + 2], P[BASE + 3]);   \
    unsigned b0_ = cvtpk(P[BASE + 4], P[BASE + 5]), b1_ = cvtpk(P[BASE + 6], P[BASE + 7]);                              \
    auto r0_ = __builtin_amdgcn_permlane32_swap(a0_, b0_, false, false); auto r1_ = __builtin_amdgcn_permlane32_swap(a1_, b1_, false, false); \
    u32x4 w_ = {r0_[0], r1_[0], r0_[1], r1_[1]}; OUT = *reinterpret_cast<bf16x8*>(&w_); } while (0)

namespace ml {
constexpr int LD = MPROJ;
constexpr int SHM_V = 64 * 128 * 2, SHM_K = 64 * 256 * 2;
constexpr int OFF_V = 0, OFF_K = 2 * SHM_V, OFF_WS = OFF_K + 2 * SHM_K, OFF_G = OFF_WS + NWAVES * 256, LDS_END = OFF_G + 2 * SEQ * 4;
static_assert(LDS_END <= RING_BYTES, "mlstm LDS");
constexpr float LOG2E = 1.4426950408889634f;

__device__ __forceinline__ void scan(Frame& F, int bh, int dir) {
    const int b = bh >> 2, h = bh & 3;
    const float* gates = (const float*)(F.ws + WS_GATE);
    float* SC = (float*)(F.ws + WS_SC) + (size_t)bh * 6 * SEQ;
    LAS float* red = (LAS float*)F.lds;
    {
        float ig[4], s[4]; int tt[4];
#pragma unroll
        for (int j = 0; j < 4; ++j) { const int p = F.tid * 4 + j, t = dir ? (SEQ - 1 - p) : p; tt[j] = t;
            const float* gr = gates + (size_t)(b * SEQ + t) * 16; ig[j] = gr[dir * 8 + h]; const float fg = gr[dir * 8 + 4 + h];
            s[j] = fminf(fg, 0.f) - log1pf(expf(-fabsf(fg))); }
        s[1] += s[0]; s[2] += s[1]; s[3] += s[2];
        const float tot = s[3]; float inc = tot;
#pragma unroll
        for (int o = 1; o < 64; o <<= 1) { const float n = __shfl_up(inc, o); if (F.lane >= o) inc += n; }
        if (F.lane == 63) red[F.wave] = inc;
        __syncthreads();
        float woff = 0.f;
        for (int w = 0; w < F.wave; ++w) woff += red[w];
        const float excl = woff + inc - tot;
        float Bv[4], g[4], pm[4];
#pragma unroll
        for (int j = 0; j < 4; ++j) { Bv[j] = excl + s[j]; g[j] = ig[j] - Bv[j]; }
        pm[0] = g[0]; pm[1] = fmaxf(pm[0], g[1]); pm[2] = fmaxf(pm[1], g[2]); pm[3] = fmaxf(pm[2], g[3]);
        float minc = pm[3];
#pragma unroll
        for (int o = 1; o < 64; o <<= 1) { const float n = __shfl_up(minc, o); if (F.lane >= o) minc = fmaxf(minc, n); }
        if (F.lane == 63) red[16 + F.wave] = minc;
        __syncthreads();
        float wmax = -3.0e38f;
        for (int w = 0; w < F.wave; ++w) wmax = fmaxf(wmax, red[16 + w]);
        const float prev = __shfl_up(minc, 1);
        const float exm = (F.lane > 0) ? fmaxf(wmax, prev) : wmax;
#pragma unroll
        for (int j = 0; j < 4; ++j) { const float c = fmaxf(0.f, fmaxf(exm, pm[j])); const float m = Bv[j] + c;
            SC[(dir * 3 + 0) * SEQ + tt[j]] = g[j] * LOG2E; SC[(dir * 3 + 1) * SEQ + tt[j]] = c * LOG2E; SC[(dir * 3 + 2) * SEQ + tt[j]] = expf(-m); }
        __syncthreads();
    }
}

}
namespace ml2 {
constexpr int LD = MPROJ;
constexpr int KT = 32;
constexpr int SHM_K = KT * 512, SHM_V = KT * 1024;
constexpr int NBUF = 3;
constexpr int OFF_K = 0, OFF_V = NBUF * SHM_K, OFF_WS = OFF_V + NBUF * SHM_V, OFF_G = OFF_WS + NWAVES * 256, LDS_END = OFF_G + SEQ * 4;
static_assert(LDS_END <= RING_BYTES, "mlstm16 LDS");

template <int DIR, int VAR = 0>
__device__ __forceinline__ void pass(const bf16* Qb, const bf16* Kh, const bf16* Vh, bf16* Hb, const float* C2g, const float* ECg, int r0u, char* lds) {
    const int tid = opaque_tid(), wid = tid >> 6, lane = tid & 63, n16 = lane & 15, g = lane >> 4, q4 = n16 >> 2, p4 = lane & 3;
    const int wu = __builtin_amdgcn_readfirstlane(wid);
    char* K_lds = lds + OFF_K; char* V_lds = lds + OFF_V;
    const float* Gf = (const float*)(lds + OFF_G);
    float* li_l = (float*)(lds + OFF_WS) + wid * 64; float* ec_l = li_l + 32;
    const int rlo = r0u + wid * 16, rhi = rlo + 15, trow = rlo + n16;
    bf16x8 qr[8];
    { const bf16* Qw = Qb + (size_t)(wid * 16 + n16) * LD + 8 * g;
#pragma unroll
      for (int s = 0; s < 8; ++s) qr[s] = *reinterpret_cast<const bf16x8*>(Qw + 32 * s); }
    const float c2 = C2g[trow], ec = ECg[trow];
    f32x4 o[32];
#pragma unroll
    for (int i = 0; i < 32; ++i) o[i] = (f32x4){0.f, 0.f, 0.f, 0.f};
    float den = 0.f;
    const int j0 = DIR == 0 ? 0 : (r0u >> 5), n = DIR == 0 ? (r0u >> 5) + 4 : 64 - (r0u >> 5);
    unsigned koff[2], voff[4];
#pragma unroll
    for (int i_ = 0; i_ < 2; ++i_) { const int row_ = 2 * (wid * 2 + i_) + (lane >> 5), kc_ = (lane & 31) ^ (row_ & 15); koff[i_] = (unsigned)(row_ * LD + kc_ * 8); }
#pragma unroll
    for (int i_ = 0; i_ < 4; ++i_) { const int pc = wid * 4 + i_, sl = pc >> 3, oo = (pc >> 1) & 3, cb = 4 * (pc & 1) + (lane >> 4), kq = (lane >> 1) & 7;
        voff[i_] = (unsigned)((8 * oo + kq) * LD + sl * 128 + 16 * cb + 8 * (lane & 1)); }
#define M2_STAGE(b, k0) do { _Pragma("unroll") for (int i_ = 0; i_ < 2; ++i_) \
        __builtin_amdgcn_global_load_lds((const unsigned*)(Kh + (size_t)(k0) * LD + koff[i_]), (LAS unsigned*)(uintptr_t)(unsigned)((unsigned)(uintptr_t)K_lds + (b) * SHM_K + (wu * 2 + i_) * 1024), 16, 0, 0); \
        _Pragma("unroll") for (int i_ = 0; i_ < 4; ++i_) \
        __builtin_amdgcn_global_load_lds((const unsigned*)(Vh + (size_t)(k0) * LD + voff[i_]), (LAS unsigned*)(uintptr_t)(unsigned)((unsigned)(uintptr_t)V_lds + (b) * SHM_V + (wu * 4 + i_) * 1024), 16, 0, 0); } while (0)
    int ksw = n16 << 4; asm volatile("" : "+v"(ksw));
    const int trb = (int)(uintptr_t)V_lds + (g >> 1) * 2048 + (4 * (g & 1) + q4) * 32 + p4 * 8;
#define M2_RD(cb, sl, L, H) L = tr_read<(sl) * 8192 + (cb) * 256>(trv); H = tr_read<(sl) * 8192 + (cb) * 256 + 4096>(trv)
#define M2_MM(cb, sl, L, H) o[(sl) * 8 + (cb)] = __builtin_amdgcn_mfma_f32_16x16x32_bf16(pa, (bf16x8){L[0], L[1], L[2], L[3], H[0], H[1], H[2], H[3]}, o[(sl) * 8 + (cb)], 0, 0, 0)
#define M2_RD4(q, L, H) do { M2_RD(4 * ((q) & 1) + 0, (q) >> 1, L##0, H##0); M2_RD(4 * ((q) & 1) + 1, (q) >> 1, L##1, H##1); M2_RD(4 * ((q) & 1) + 2, (q) >> 1, L##2, H##2); M2_RD(4 * ((q) & 1) + 3, (q) >> 1, L##3, H##3); } while (0)
#define M2_MM4(q, L, H) do { M2_MM(4 * ((q) & 1) + 0, (q) >> 1, L##0, H##0); M2_MM(4 * ((q) & 1) + 1, (q) >> 1, L##1, H##1); M2_MM(4 * ((q) & 1) + 2, (q) >> 1, L##2, H##2); M2_MM(4 * ((q) & 1) + 3, (q) >> 1, L##3, H##3); } while (0)
#define M2_WAIT8() do { asm volatile("s_waitcnt lgkmcnt(8)" ::: "memory"); SBAR(); } while (0)
#define M2_WAIT0() do { asm volatile("s_waitcnt lgkmcnt(0)" ::: "memory"); SBAR(); } while (0)
#define M2_PV() do { s16x4 xa0, xa1, xa2, xa3, ya0, ya1, ya2, ya3, xb0, xb1, xb2, xb3, yb0, yb1, yb2, yb3; \
        M2_RD4(0, xa, ya); \
        M2_RD4(1, xb, yb); M2_WAIT8(); M2_MM4(0, xa, ya); \
        M2_RD4(2, xa, ya); M2_WAIT8(); M2_MM4(1, xb, yb); \
        M2_RD4(3, xb, yb); M2_WAIT8(); M2_MM4(2, xa, ya); \
        M2_RD4(4, xa, ya); M2_WAIT8(); M2_MM4(3, xb, yb); \
        M2_RD4(5, xb, yb); M2_WAIT8(); M2_MM4(4, xa, ya); \
        M2_RD4(6, xa, ya); M2_WAIT8(); M2_MM4(5, xb, yb); \
        M2_RD4(7, xb, yb); M2_WAIT8(); M2_MM4(6, xa, ya); \
        M2_WAIT0(); M2_MM4(7, xb, yb); } while (0)
    { float* Gl = (float*)(lds + OFF_G); const float* Gs = C2g - SEQ;
      for (int i = tid; i < SEQ; i += NTHREADS) Gl[i] = Gs[i]; }
    M2_STAGE(0, j0 * KT); M2_STAGE(1, (j0 + 1) * KT);
    asm volatile("s_waitcnt vmcnt(6)" ::: "memory"); __syncthreads();
    for (int i = 0; i < n; ++i) {
        const int cur = i % NBUF, k0 = (j0 + i) * KT;
        if (VAR != 1 && i + 2 < n) M2_STAGE((i + 2) % NBUF, k0 + 2 * KT);
        const bool full = DIR == 0 ? (k0 + KT - 1 <= rlo) : (k0 >= rhi);
        const bool none = DIR == 0 ? (k0 > rhi) : (k0 + KT - 1 < rlo);
        if (!none) {
            f32x4 p0 = {0.f, 0.f, 0.f, 0.f}, p1 = {0.f, 0.f, 0.f, 0.f};
            if (VAR != 3) { const char* Kc = K_lds + cur * SHM_K + n16 * 512;
#pragma unroll
              for (int s = 0; s < 8; ++s) { const int off = (64 * s + 16 * g) ^ ksw;
                  const bf16x8 a0 = *reinterpret_cast<const bf16x8*>(Kc + off), a1 = *reinterpret_cast<const bf16x8*>(Kc + 8192 + off);
                  p0 = __builtin_amdgcn_mfma_f32_16x16x32_bf16(a0, qr[s], p0, 0, 0, 0);
                  p1 = __builtin_amdgcn_mfma_f32_16x16x32_bf16(a1, qr[s], p1, 0, 0, 0); } }
            const f32x4 ga = *reinterpret_cast<const f32x4*>(Gf + k0 + 4 * g), gb = *reinterpret_cast<const f32x4*>(Gf + k0 + 16 + 4 * g);
            float ps = 0.f;
#pragma unroll
            for (int r = 0; r < 4; ++r) {
                float w0 = __builtin_amdgcn_exp2f(ga[r] - c2), w1 = __builtin_amdgcn_exp2f(gb[r] - c2);
                if (!full) { const int key = k0 + 4 * g + r;
                    const bool ok0 = DIR == 0 ? (key <= trow) : (key >= trow), ok1 = DIR == 0 ? (key + 16 <= trow) : (key + 16 >= trow);
                    w0 = ok0 ? w0 : 0.f; w1 = ok1 ? w1 : 0.f; }
                p0[r] *= w0; p1[r] *= w1; ps += p0[r] + p1[r]; }
            ps += __shfl_xor(ps, 16); ps += __shfl_xor(ps, 32);
            den += ps;
            u32x4 paw = {cvtpk(p0[0], p0[1]), cvtpk(p0[2], p0[3]), cvtpk(p1[0], p1[1]), cvtpk(p1[2], p1[3])};
            const bf16x8 pa = *reinterpret_cast<bf16x8*>(&paw);
            const int trv = trb + cur * SHM_V;
            SBAR();
            if (VAR != 2) M2_PV();
        }
        if (VAR != 1 && i + 2 < n) asm volatile("s_waitcnt vmcnt(6)" ::: "memory"); else asm volatile("s_waitcnt vmcnt(0)" ::: "memory");
        if (VAR != 4) __syncthreads();
    }
#undef M2_PV
#undef M2_WAIT0
#undef M2_WAIT8
#undef M2_MM4
#undef M2_RD4
#undef M2_MM
#undef M2_RD
#undef M2_STAGE
    if (g == 0) { li_l[n16] = den; ec_l[n16] = ec; }
    asm volatile("s_waitcnt lgkmcnt(0)" ::: "memory");
    float rs[4];
#pragma unroll
    for (int r = 0; r < 4; ++r) rs[r] = __builtin_amdgcn_rcpf(fmaxf(fabsf(li_l[4 * g + r]), ec_l[4 * g + r]));
    GAS bf16* Hw = (GAS bf16*)(Hb + (size_t)(wid * 16 + 4 * g) * DM + n16);
    asm volatile("" : "+v"(Hw));
#pragma unroll
    for (int sl = 0; sl < 4; ++sl)
#pragma unroll
        for (int cb = 0; cb < 8; ++cb)
#pragma unroll
            for (int r = 0; r < 4; ++r) { if (VAR != 5) Hw[(size_t)r * DM + sl * 128 + cb * 16] = (bf16)f2bf(o[sl * 8 + cb][r] * rs[r]); else asm volatile("" :: "v"(o[sl * 8 + cb][r] * rs[r])); }
    asm volatile("s_waitcnt lgkmcnt(0)" ::: "memory");
}

template <int VAR = 0>
__device__ __forceinline__ void phase(Frame& F) {
    const bf16* PROJ = (const bf16*)(F.ws + WS_PROJ); bf16* HS = (bf16*)(F.ws + (VAR ? WS_PSCR : WS_HS)); bf16* HS2 = (bf16*)(F.ws + (VAR ? WS_PSCR : WS_XB1)); bf16* HB = (bf16*)(F.ws + (VAR ? WS_PSCR : WS_HB));
    const float* hn = (const float*)F.in[5];
    const int G = F.G; const int x = blockIdx.x & 7, jx = blockIdx.x >> 3, per = G >> 3;
    const bool loc = (G % 8 == 0);
    for (int v = loc ? jx : (int)blockIdx.x; v < (loc ? 64 : 512); v += (loc ? per : G)) {
        const int bh = loc ? (4 * x + (v >> 4)) : (v >> 4), blk = v & 15;
        const int b = bh >> 2, h = bh & 3, r0u = blk * 128;
        const float* SC = (const float*)(F.ws + WS_SC) + (size_t)bh * 6 * SEQ;
        const bf16* rowb = PROJ + (size_t)(b * SEQ) * LD;
        const bf16* Qb = rowb + (size_t)r0u * LD + h * MDK;
        const bf16* Kh = rowb + 1024 + h * MDK;
        const bf16* Vh = rowb + 2048 + h * MDV;
        const size_t ho = (size_t)(b * SEQ + r0u) * DM + h * MDV;
        pass<0, (VAR > 0 ? VAR - 1 : 0)>(Qb, Kh, Vh, HS + ho, SC + 1 * SEQ, SC + 2 * SEQ, r0u, (char*)F.lds);
        pass<1, (VAR > 0 ? VAR - 1 : 0)>(Qb, Kh, Vh, HS2 + ho, SC + 4 * SEQ, SC + 5 * SEQ, r0u, (char*)F.lds);
        asm volatile("s_waitcnt vmcnt(0)" ::: "memory");
        { const int wid = F.wave, lane = F.lane;
          const f32x4 wa = *(const f32x4*)(hn + h * MDV + lane * 8), wb = *(const f32x4*)(hn + h * MDV + lane * 8 + 4);
          const float w[8] = {wa[0], wa[1], wa[2], wa[3], wb[0], wb[1], wb[2], wb[3]};
          for (int rr = 0; rr < 16; rr += 4) {
              u32x4 hv[4], hw[4], ov[4];
#pragma unroll
              for (int q = 0; q < 4; ++q) { const size_t ro = ho + (size_t)(wid * 16 + rr + q) * DM + lane * 8;
                  hv[q] = *(const u32x4*)(HS + ro); hw[q] = *(const u32x4*)(HS2 + ro);
                  ov[q] = *(const u32x4*)(PROJ + (size_t)(b * SEQ + r0u + wid * 16 + rr + q) * LD + 4096 + h * MDV + lane * 8); }
#pragma unroll
              for (int q = 0; q < 4; ++q) {
                  float v[8] = {bf_lo(hv[q].x) + bf_lo(hw[q].x), bf_hi(hv[q].x) + bf_hi(hw[q].x), bf_lo(hv[q].y) + bf_lo(hw[q].y), bf_hi(hv[q].y) + bf_hi(hw[q].y),
                                bf_lo(hv[q].z) + bf_lo(hw[q].z), bf_hi(hv[q].z) + bf_hi(hw[q].z), bf_lo(hv[q].w) + bf_lo(hw[q].w), bf_hi(hv[q].w) + bf_hi(hw[q].w)};
                  const float og[8] = {bf_lo(ov[q].x), bf_hi(ov[q].x), bf_lo(ov[q].y), bf_hi(ov[q].y), bf_lo(ov[q].z), bf_hi(ov[q].z), bf_lo(ov[q].w), bf_hi(ov[q].w)};
                  float ss = 0.f;
#pragma unroll
                  for (int k = 0; k < 8; ++k) ss += v[k] * v[k];
                  const float rstd = 1.0f / sqrtf(wave_sum(ss) * (1.0f / MDV) + NORM_EPS);
#pragma unroll
                  for (int k = 0; k < 8; ++k) v[k] = v[k] * rstd * w[k] * og[k];
                  u32x4 oo; oo.x = cvtpk(v[0], v[1]); oo.y = cvtpk(v[2], v[3]); oo.z = cvtpk(v[4], v[5]); oo.w = cvtpk(v[6], v[7]);
                  *(u32x4*)(HB + ho + (size_t)(wid * 16 + rr + q) * DM + lane * 8) = oo; }
          }
        }
    }
    __syncthreads();
}
}
namespace at {
#ifndef ATT_OUT_SCALE
#define ATT_OUT_SCALE 1.0f
#endif
constexpr int D = 128, QBLK = 32, KVBLK = 64;
constexpr float SCALE = 0.088388347648318440f;
constexpr float THR = 8.f;
constexpr int SDEPTH = 1;
constexpr int LDQ = APROJ, LDK = APROJ, LDO = DM;
constexpr int SHM_V = KVBLK * D * 2, SHM_K = KVBLK * D * 2, SHM_ATTN = 2 * SHM_V + 2 * SHM_K + NWAVES * 64 * 4;
static_assert(SHM_ATTN <= RING_BYTES, "attn LDS");
#define KSWZ(row, colB) ((row) * 256 + ((colB) ^ (((row) & 7) << 4)))

__device__ __forceinline__ void partialSM(f32x16& p0, f32x16& p1, float& m_reg, float& mn, float& alpha) {
    constexpr float C = SCALE * 1.4426950408889634f;
    float pmax = p0[0];
#pragma unroll
    for (int r = 1; r < 16; ++r) pmax = fmaxf(pmax, p0[r]);
#pragma unroll
    for (int r = 0; r < 16; ++r) pmax = fmaxf(pmax, p1[r]);
    { auto rr = __builtin_amdgcn_permlane32_swap(__float_as_uint(pmax), __float_as_uint(pmax), false, false);
      pmax = fmaxf(__uint_as_float(rr[0]), __uint_as_float(rr[1])); }
    if (__builtin_expect(__all(pmax - m_reg <= THR / SCALE), 1)) { mn = m_reg; alpha = 1.f; }
    else { mn = fmaxf(m_reg, pmax); alpha = __builtin_amdgcn_exp2f((m_reg - mn) * C); m_reg = mn; }
    const float mnC = -mn * C;
#pragma unroll
    for (int r = 0; r < 16; ++r) p0[r] = fmaf(p0[r], C, mnC);
#pragma unroll
    for (int r = 0; r < 16; ++r) p1[r] = fmaf(p1[r], C, mnC);
#pragma unroll
    for (int r = 0; r < 16; ++r) p0[r] = __builtin_amdgcn_exp2f(p0[r]);
}
__device__ __forceinline__ void finishSM(f32x16& p0, f32x16& p1, float alpha, float& l_reg, bf16x8& pa0, bf16x8& pa1, bf16x8& pa2, bf16x8& pa3) {
#pragma unroll
    for (int r = 0; r < 16; ++r) p1[r] = __builtin_amdgcn_exp2f(p1[r]);
    float ps = 0;
#pragma unroll
    for (int r = 0; r < 16; ++r) ps += p0[r];
#pragma unroll
    for (int r = 0; r < 16; ++r) ps += p1[r];
    { auto rr = __builtin_amdgcn_permlane32_swap(__float_as_uint(ps), __float_as_uint(ps), false, false);
      ps = __uint_as_float(rr[0]) + __uint_as_float(rr[1]); }
    l_reg = l_reg * alpha + ps;
    PK4(p0, 0, pa0); PK4(p0, 8, pa1); PK4(p1, 0, pa2); PK4(p1, 8, pa3);
}
__device__ __forceinline__ void attn_dense_body(const bf16* __restrict__ Qb, const bf16* __restrict__ Kh, const bf16* __restrict__ Vh, bf16* __restrict__ Ob, int seq, char* lds) {
    const int tid = opaque_tid(), wid = tid >> 6, lane = tid & 63, r32 = lane & 31, hi = lane >> 5;
    char* V_lds = lds; char* K_lds = lds + 2 * SHM_V;
    float* wsf = (float*)(lds + 2 * SHM_V + 2 * SHM_K) + wid * 64; float* li_l = wsf; float* al_l = wsf + 32;
    float m_reg = -1e30f, l_reg = 0; f32x16 o[4] = {}; bf16x8 qr[8];
    const bf16* Qw = Qb + (long)(wid * QBLK + r32) * LDQ + hi * 8;
#pragma unroll
    for (int d0 = 0; d0 < 8; ++d0) qr[d0] = *reinterpret_cast<const bf16x8*>(Qw + d0 * 16);
    const int sr = tid >> 4, sc = (tid & 15) * 8, vst0 = v_st(sr, sc), vst1 = v_st(32 + sr, sc);
    const int vb0 = (int)(uintptr_t)V_lds + v_rd_base(lane);
    struct { bf16x8 vs0, vs1, ks0, ks1; } sr_[SDEPTH];
#define SLOAD(i, k0) do { sr_[i].vs0 = *reinterpret_cast<const bf16x8*>(&Vh[(long)((k0) + sr) * LDK + sc]); sr_[i].vs1 = *reinterpret_cast<const bf16x8*>(&Vh[(long)((k0) + 32 + sr) * LDK + sc]); \
    sr_[i].ks0 = *reinterpret_cast<const bf16x8*>(&Kh[(long)((k0) + sr) * LDK + sc]); sr_[i].ks1 = *reinterpret_cast<const bf16x8*>(&Kh[(long)((k0) + 32 + sr) * LDK + sc]); } while (0)
#define SWRITE(b, i) do { *(bf16x8*)(V_lds + (b) * SHM_V + vst0) = sr_[i].vs0;          \
    *(bf16x8*)(V_lds + (b) * SHM_V + vst1) = sr_[i].vs1; int kc_ = sc * 2;               \
    *(bf16x8*)(K_lds + (b) * SHM_K + KSWZ(sr, kc_)) = sr_[i].ks0;                       \
    *(bf16x8*)(K_lds + (b) * SHM_K + KSWZ(32 + sr, kc_)) = sr_[i].ks1; } while (0)
#define SWAIT() do { if constexpr (SDEPTH == 2) asm volatile("s_waitcnt vmcnt(4)" ::: "memory"); else asm volatile("s_waitcnt vmcnt(0)" ::: "memory"); } while (0)
#define RESC(a) do { if (__any((a) < 1.f)) { if (hi == 0) al_l[r32] = (a); asm volatile("s_waitcnt lgkmcnt(0)" ::: "memory"); \
    _Pragma("unroll") for (int d = 0; d < 4; ++d) _Pragma("unroll") for (int r = 0; r < 16; ++r) o[d][r] *= al_l[crow(r, hi)]; } } while (0)
    f32x16 pA0, pA1, pB0, pB1; float mnA, mnB, alA, alB; bf16x8 pa0, pa1, pa2, pa3; const int NT = seq / KVBLK;
    constexpr int SE = 0, SO = SDEPTH - 1;
    SLOAD(SE, 0); asm volatile("s_waitcnt vmcnt(0)" ::: "memory"); SWRITE(0, SE); __syncthreads();
    qkt<8, 256>(pA0, pA1, K_lds, qr, r32, hi); partialSM(pA0, pA1, m_reg, mnA, alA);
    SLOAD(SO, KVBLK); if constexpr (SDEPTH == 2) { if (2 < NT) SLOAD(SE, 2 * KVBLK); }
    SWAIT(); SWRITE(1, SO); __syncthreads();
    for (int j = 1; j + 1 < NT; j += 2) {
        SBAR(); qkt<8, 256>(pB0, pB1, K_lds + SHM_K, qr, r32, hi);
        finishSM(pA0, pA1, alA, l_reg, pa0, pa1, pa2, pa3); SBAR();
        SLOAD(SO, (j + SDEPTH) * KVBLK); SBAR();
        pv_d0(o, vb0, pa0, pa1, pa2, pa3); partialSM(pB0, pB1, m_reg, mnB, alB);
        __syncthreads(); SWAIT(); SWRITE(0, SE);
        RESC(alB); __syncthreads();
        SBAR(); qkt<8, 256>(pA0, pA1, K_lds, qr, r32, hi);
        finishSM(pB0, pB1, alB, l_reg, pa0, pa1, pa2, pa3); SBAR();
        if (SDEPTH == 1 || j + 3 < NT) SLOAD(SE, (j + 1 + SDEPTH) * KVBLK); SBAR();
        pv_d0(o, vb0 + (int)SHM_V, pa0, pa1, pa2, pa3); partialSM(pA0, pA1, m_reg, mnA, alA);
        __syncthreads(); SWAIT(); SWRITE(1, SO);
        RESC(alA); __syncthreads();
    }
    SBAR(); qkt<8, 256>(pB0, pB1, K_lds + SHM_K, qr, r32, hi);
    finishSM(pA0, pA1, alA, l_reg, pa0, pa1, pa2, pa3); SBAR();
    pv_d0(o, vb0, pa0, pa1, pa2, pa3); partialSM(pB0, pB1, m_reg, mnB, alB);
    __syncthreads(); RESC(alB);
    finishSM(pB0, pB1, alB, l_reg, pa0, pa1, pa2, pa3); SBAR();
    pv_d0(o, vb0 + (int)SHM_V, pa0, pa1, pa2, pa3);
    if (hi == 0) li_l[r32] = l_reg; asm volatile("s_waitcnt lgkmcnt(0)" ::: "memory");
    float rli[16];
#pragma unroll
    for (int r = 0; r < 16; ++r) rli[r] = __builtin_amdgcn_rcpf(li_l[crow(r, hi)]);
    bf16* Ow = Ob + (long)(wid * QBLK) * LDO;
#pragma unroll
    for (int r = 0; r < 16; ++r) { const int orow = crow(r, hi);
#pragma unroll
        for (int d0 = 0; d0 < 4; ++d0) Ow[(long)orow * LDO + d0 * 32 + r32] = (bf16)f2bf(o[d0][r] * rli[r] * ATT_OUT_SCALE); }
    asm volatile("s_waitcnt lgkmcnt(0)" ::: "memory");
    __syncthreads();
#undef SLOAD
#undef SWRITE
#undef SWAIT
#undef RESC
}
__device__ __forceinline__ void rope_phase(Frame& F) {
    bf16* P = (bf16*)(F.ws + WS_PROJ);
    const float* qn = (const float*)F.in[8]; const float* kn = (const float*)F.in[9];
    const float* cosT = (const float*)(F.ws + WS_ROPE); const float* sinT = cosT + SEQ * 64;
    const float* part = (const float*)(F.ws + WS_PART);
    const int gw = blockIdx.x * NWAVES + F.wave, NGW = F.G * NWAVES, lane = F.lane;
    const float q0 = qn[2 * lane], q1 = qn[2 * lane + 1], k0 = kn[2 * lane], k1 = kn[2 * lane + 1];
    for (int tok = gw; tok < TOK; tok += NGW) {
        const int t = tok & (SEQ - 1);
        unsigned* p = (unsigned*)(P + (size_t)tok * APROJ) + lane;
        unsigned w[24];
#pragma unroll
        for (int hs = 0; hs < 24; ++hs) w[hs] = p[hs * 64];
        const float pp = lane < 32 ? part[(size_t)tok * 32 + lane] : 0.f;
        const float c = cosT[t * 64 + lane], s = sinT[t * 64 + lane];
        const float r2 = 1.0f / (wave_sum(pp) * (1.0f / DM) + NORM_EPS);
        const float rstd = sqrtf(r2), epsq = NORM_EPS / r2;
#pragma unroll
        for (int hs = 0; hs < 24; ++hs) {
            const float x1 = bf_lo(w[hs]), x2 = bf_hi(w[hs]);
            if (hs >= 20) { p[hs * 64] = cvtpk(x1 * rstd, x2 * rstd); continue; }
            const float rs = 1.0f / sqrtf(wave_sum(x1 * x1 + x2 * x2) * (1.0f / 128.0f) + epsq);
            const float y1 = x1 * rs * (hs < 16 ? q0 : k0), y2 = x2 * rs * (hs < 16 ? q1 : k1);
            p[hs * 64] = cvtpk(y1 * c - y2 * s, y1 * s + y2 * c);
        }
    }
}
__device__ __forceinline__ void phase(Frame& F) {
    const bf16* P = (const bf16*)(F.ws + WS_PROJ); bf16* OB = (bf16*)(F.ws + WS_HB);
    const int G = F.G; const int x = blockIdx.x & 7, jx = blockIdx.x >> 3, per = G >> 3;
    for (int u = (G % 8 == 0) ? (x * per + jx) : (int)blockIdx.x; u < 1024; u += G) {
        const int bk = u >> 5, hg = (u >> 3) & 3, qb = u & 7, b = bk >> 2, kvh = bk & 3, h = kvh * 4 + hg;
        const bf16* rowb = P + (size_t)(b * SEQ) * APROJ;
        attn_dense_body(rowb + (size_t)(qb * 256) * APROJ + h * D, rowb + 2048 + kvh * D, rowb + 2560 + kvh * D,
                        OB + (size_t)(b * SEQ + qb * 256) * DM + h * D, SEQ, (char*)F.lds);
    }
}
}
namespace tk {
constexpr int OFF_K1 = 0, OFF_K2 = 32768, OFF_SCR = 65536;
static_assert(OFF_SCR + NWAVES * 4096 <= RING_BYTES, "topk LDS");
__device__ __forceinline__ void ce(unsigned& a, unsigned& b) { const unsigned mx = a > b ? a : b, mn = a > b ? b : a; a = mx; b = mn; }
__device__ __forceinline__ void sort16(unsigned (&k)[16]) {
#pragma unroll
    for (int sz = 2; sz <= 16; sz <<= 1)
#pragma unroll
        for (int st = sz >> 1; st > 0; st >>= 1)
#pragma unroll
            for (int i = 0; i < 16; ++i) { const int j = i ^ st; if (j > i) { if ((i & sz) == 0) ce(k[i], k[j]); else ce(k[j], k[i]); } }
}
__device__ __forceinline__ void merge16(unsigned (&a)[16], const unsigned (&b)[16]) {
#pragma unroll
    for (int i = 0; i < 16; ++i) a[i] = a[i] > b[15 - i] ? a[i] : b[15 - i];
#pragma unroll
    for (int st = 8; st > 0; st >>= 1)
#pragma unroll
        for (int i = 0; i < 16; ++i) { const int j = i ^ st; if (j > i) ce(a[i], a[j]); }
}
__device__ __forceinline__ void xmerge16(unsigned (&a)[16]) {
    unsigned x[16], y[16];
#pragma unroll
    for (int i = 0; i < 16; ++i) { auto rr = __builtin_amdgcn_permlane32_swap(a[i], a[i], false, false); x[i] = rr[0]; y[i] = rr[1]; }
    merge16(x, y);
#pragma unroll
    for (int i = 0; i < 16; ++i) a[i] = x[i];
}
__device__ __forceinline__ unsigned f2key(float f) { const unsigned u = __float_as_uint(f); return u ^ ((unsigned)((int)u >> 31) | 0x80000000u); }
__device__ __forceinline__ float key2f(unsigned k, unsigned mask) { k &= ~mask; const unsigned u = (k & 0x80000000u) ? (k ^ 0x80000000u) : ~k; return __uint_as_float(u & ~mask); }
template <int VAR>
__device__ __forceinline__ void half_topk(unsigned (&t)[16], const bf16* qrow, const char* Kl, int r32, int hi) {
    bf16x8 qr[8];
#pragma unroll
    for (int d0 = 0; d0 < 8; ++d0) qr[d0] = *reinterpret_cast<const bf16x8*>(qrow + d0 * 16);
    f32x16 a0, a1, a2, a3;
    if (VAR != 3) { qkt<8, 256>(a0, a1, Kl, qr, r32, hi); qkt<8, 256>(a2, a3, Kl + 64 * 256, qr, r32, hi); }
    else { a0 = f32x16{}; a1 = a0; a2 = a0; a3 = a0; a0[0] = __uint_as_float((unsigned)qr[0][0]); a1[1] = __uint_as_float((unsigned)qr[7][1]); }
    unsigned kb[16], kc[16], kd[16];
#pragma unroll
    for (int r = 0; r < 16; ++r) { const unsigned base = 127u - (unsigned)((r & 3) + 8 * (r >> 2)) - 4u * (unsigned)hi;
        t[r]  = (f2key(a0[r]) & ~127u) | (base);
        kb[r] = (f2key(a1[r]) & ~127u) | (base - 32u);
        kc[r] = (f2key(a2[r]) & ~127u) | (base - 64u);
        kd[r] = (f2key(a3[r]) & ~127u) | (base - 96u); }
    if (VAR != 2) { sort16(t); sort16(kb); sort16(kc); sort16(kd);
    merge16(t, kb); merge16(kc, kd); merge16(t, kc);
    xmerge16(t); } else { for (int r = 0; r < 16; ++r) t[r] ^= kb[r] + kc[r] + kd[r]; }
}
struct Cand { int i, j; };
constexpr Cand cand_at(int n) {
    int c = 0;
    for (int i = 0; i < 16; ++i) for (int j = 0; j < 16; ++j) if ((i + 1) * (j + 1) <= 16) { if (c == n) return Cand{i, j}; ++c; }
    return Cand{0, 0};
}
template <int N> __device__ __forceinline__ unsigned cand_key(const float (&v1)[16], const float (&v2)[16], int hi) {
    constexpr Cand A = cand_at(N), B = cand_at(25 + N);
    const float s = hi ? (v1[B.i] + v2[B.j]) : (v1[A.i] + v2[A.j]);
    const unsigned pl = hi ? (unsigned)(B.i * 16 + B.j) : (unsigned)(A.i * 16 + A.j);
    return (f2key(s) & ~255u) | pl;
}
template <int N> struct CandFill { static __device__ __forceinline__ void run(unsigned (&c)[32], const float (&v1)[16], const float (&v2)[16], int hi) { c[N] = cand_key<N>(v1, v2, hi); CandFill<N + 1>::run(c, v1, v2, hi); } };
template <> struct CandFill<25> { static __device__ __forceinline__ void run(unsigned (&)[32], const float (&)[16], const float (&)[16], int) {} };
template <int VAR = 0>
__device__ __forceinline__ void phase(Frame& F, int layer, const bf16* PQ) {
    const int tid = F.tid, wid = F.wave, lane = F.lane, r32 = lane & 31, hi = lane >> 5;
    char* lds = (char*)F.lds;
    const bf16* pk = (const bf16*)(F.ws + WS_PK) + (size_t)layer * 2 * PKEYS * PHALF;
    const float* part = (const float*)(F.ws + WS_PART);
    int* idx_out = (int*)(F.ws + (VAR ? WS_PSCR : WS_IDX)); float* gate_out = (float*)(F.ws + (VAR ? WS_PSCR + 16 * MiB : WS_GSM));
    __syncthreads();
#pragma unroll
    for (int i = 0; i < 8; ++i) { const int c = tid + NTHREADS * i, which = c >> 11, rc = c & 2047, row = rc >> 4, ch = rc & 15;
        const u32x4 v = *(const u32x4*)(pk + (size_t)which * PKEYS * PHALF + row * PHALF + ch * 8);
        *(u32x4*)(lds + which * 32768 + row * 256 + ((ch * 16) ^ ((row & 7) << 4))) = v; }
    __syncthreads();
    int* scr = (int*)(lds + OFF_SCR + wid * 4096) + r32 * 32;
    for (int unit = blockIdx.x; unit < TOK / 32; unit += F.G) {
        const int tok = unit * 32 + r32, head = wid;
        const bf16* qrow = PQ + (size_t)tok * DM + head * 256 + hi * 8;
        unsigned t1[16], t2[16];
        half_topk<VAR>(t1, qrow, lds + OFF_K1, r32, hi);
        half_topk<VAR>(t2, qrow + PHALF, lds + OFF_K2, r32, hi);
        float v1[16], v2[16];
#pragma unroll
        for (int i = 0; i < 16; ++i) { v1[i] = key2f(t1[i], 127u); v2[i] = key2f(t2[i], 127u); }
        if (hi == 0) {
#pragma unroll
            for (int i = 0; i < 16; ++i) { scr[i] = 127 - (int)(t1[i] & 127u); scr[16 + i] = 127 - (int)(t2[i] & 127u); }
        }
        unsigned cc[32];
#pragma unroll
        for (int n = 25; n < 32; ++n) cc[n] = 0u;
        CandFill<0>::run(cc, v1, v2, hi);
        unsigned ca[16], cb[16];
#pragma unroll
        for (int n = 0; n < 16; ++n) { ca[n] = cc[n]; cb[n] = cc[16 + n]; }
        if (VAR != 2) { sort16(ca); sort16(cb); merge16(ca, cb); xmerge16(ca); } else { for (int n = 0; n < 16; ++n) ca[n] ^= cb[n]; }
        float ssq = 0.f;
#pragma unroll
        for (int q = 0; q < 8; ++q) { const f32x4 pp = *(const f32x4*)(part + (size_t)tok * 32 + q * 4); ssq += (pp[0] + pp[1]) + (pp[2] + pp[3]); }
        const float rstd = 1.0f / sqrtf(ssq * (1.0f / DM) + NORM_EPS);
        float e[16]; float esum = 0.f; const float top = key2f(ca[0], 255u);
#pragma unroll
        for (int k = 0; k < 16; ++k) { e[k] = __expf((key2f(ca[k], 255u) - top) * rstd); esum += e[k]; }
        const float inv = 1.0f / esum;
        asm volatile("s_waitcnt lgkmcnt(0)" ::: "memory");
        int eo[8]; float go[8];
#pragma unroll
        for (int k = 0; k < 8; ++k) { const unsigned key = hi ? ca[8 + k] : ca[k]; const int pl = (int)(key & 255u);
            eo[k] = scr[pl >> 4] * PKEYS + scr[16 + (pl & 15)]; go[k] = (hi ? e[8 + k] : e[k]) * inv; }
        unsigned* io = (unsigned*)idx_out + (size_t)tok * (PE / 2) + head * 8 + hi * 4; float* gg = gate_out + (size_t)tok * PE + head * 16 + hi * 8;
        *(u32x4*)io = (u32x4){(unsigned)eo[0] | ((unsigned)eo[1] << 16), (unsigned)eo[2] | ((unsigned)eo[3] << 16), (unsigned)eo[4] | ((unsigned)eo[5] << 16), (unsigned)eo[6] | ((unsigned)eo[7] << 16)};
        *(f32x4*)gg = (f32x4){go[0], go[1], go[2], go[3]}; *(f32x4*)(gg + 4) = (f32x4){go[4], go[5], go[6], go[7]};
        asm volatile("s_waitcnt lgkmcnt(0)" ::: "memory");
    }
    __syncthreads();
}
}

namespace pg {
__device__ __forceinline__ float gelu_tanh(float x) {
    const float u = 0.7978845608028654f * (x + 0.044715f * x * x * x);
    const float e = __expf(2.0f * u); const float th = 1.0f - 2.0f * __builtin_amdgcn_rcpf(e + 1.0f);
    return 0.5f * x * (1.0f + th);
}
struct Place { int ord, nx, lw, nlw; };
constexpr int NSL4 = 8, SLW4 = 256, SLB4 = 128;
typedef int i32x8 __attribute__((ext_vector_type(8)));
template <int VAR>
__device__ __forceinline__ void phase_u4(Frame& F, const Place& pl, int layer, const bf16* xbin, float* P) {
    const int lane = F.lane, j = lane >> 3, c = lane & 7, i16 = lane & 15, g = lane >> 4;
    const unsigned char* ub = (const unsigned char*)(F.ws + WS_UB) + (size_t)layer * PEXP * (DM / 2);
    const __amdgpu_buffer_rsrc_t irs = __builtin_amdgcn_make_buffer_rsrc((void*)(F.ws + WS_IDX), 0, TOK * PE * 2, 0x00020000);
    const __amdgpu_buffer_rsrc_t xrs = __builtin_amdgcn_make_buffer_rsrc((void*)xbin, 0, TOK * DM * 2, 0x00020000);
    const __amdgpu_buffer_rsrc_t prs = __builtin_amdgcn_make_buffer_rsrc((void*)P, 0, TOK * NSL4 * PE * 4, 0x00020000);
    const int bsrc = (j >> 1) * 4, bsh = (j & 1) * 16;
    const int tile = (int)(uintptr_t)((char*)F.lds) + F.wave * 16384, xs = (int)(uintptr_t)((char*)F.lds) + 131072 + F.wave * 256;
    const int wr0 = tile + j * 128 + ((c ^ (j >> 1)) * 16), wr1 = tile + j * 128 + ((c ^ (4 + (j >> 1))) * 16);
    const int ard0 = tile + i16 * 128 + ((g ^ (i16 >> 1)) * 16), ard1 = tile + i16 * 128 + (((4 + g) ^ (i16 >> 1)) * 16);
    for (int s = pl.ord; s < NSL4; s += pl.nx) {
        const __amdgpu_buffer_rsrc_t rs = __builtin_amdgcn_make_buffer_rsrc((void*)(ub + (size_t)s * PEXP * SLB4), 0, PEXP * SLB4, 0x00020000);
        u32x4 rA[16], rB[16]; u32x2 xA, xB;
        unsigned idwA = __builtin_amdgcn_raw_buffer_load_b32(irs, (pl.lw * (PE / 2) + lane) * 4, 0, 0), idwB = 0;
#define PU_ISSUE(r, xr, t, idw, idnext) do { __builtin_amdgcn_sched_barrier(0); \
            { const int tn_ = ((t) + pl.nlw < TOK) ? (t) + pl.nlw : (t); idnext = __builtin_amdgcn_raw_buffer_load_b32(irs, (tn_ * (PE / 2) + lane) * 4, 0, 0); } asm volatile("" ::: "memory"); \
            _Pragma("unroll") for (int b = 0; b < 16; ++b) { const int e_ = (int)((unsigned)__builtin_amdgcn_ds_bpermute(bsrc + 16 * b, (int)idw) >> bsh) & (VAR == 2 ? 0x3ff : 0xffff); \
                if (VAR == 3) r[b] = (u32x4){(unsigned)e_, 1u, 2u, 3u}; else r[b] = __builtin_amdgcn_raw_buffer_load_b128(rs, e_ * SLB4 + c * 16, 0, 0); } \
            xr = __builtin_amdgcn_raw_buffer_load_b64(xrs, ((t) * DM + s * SLW4 + 4 * lane) * 2, 0, 0); \
            asm volatile("" ::: "memory"); __builtin_amdgcn_sched_barrier(0); } while (0)
#define PU_MF(beta, ad, bq) { const u32x4 a_ = *(LAS u32x4*)(uintptr_t)(unsigned)((ad) + 2048 * (beta)); \
            acc[beta] = __builtin_amdgcn_mfma_scale_f32_16x16x128_f8f6f4((i32x8){(int)a_.x, (int)a_.y, (int)a_.z, (int)a_.w, 0, 0, 0, 0}, bq, acc[beta], 4, 0, 0, 0x7f7f7f7f, 0, 0x7f7f7f7f); }
#define PU_COMPUTE(r, xr, t, valid) do { \
            if (VAR == 1) { u32x4 z_ = r[0]; _Pragma("unroll") for (int b = 1; b < 16; ++b) z_ = z_ ^ r[b]; z_.x ^= xr.x ^ xr.y; \
                __builtin_amdgcn_raw_buffer_store_b128(z_, prs, (i16 < 8 && (valid)) ? (((t) * NSL4 + s) * PE + 16 * i16 + 4 * g) * 4 : 0x7ffffff0, 0, 0); break; } \
            _Pragma("unroll") for (int b = 0; b < 16; ++b) *(LAS u32x4*)(uintptr_t)(unsigned)(((b & 1) ? wr1 : wr0) + 1024 * b) = r[b]; \
            { const float x0 = __uint_as_float(xr.x << 16), x1 = __uint_as_float(xr.x & 0xffff0000u), x2 = __uint_as_float(xr.y << 16), x3 = __uint_as_float(xr.y & 0xffff0000u); \
              int pk = __builtin_amdgcn_cvt_pk_fp8_f32(__builtin_amdgcn_fmed3f(x0, -448.f, 448.f), __builtin_amdgcn_fmed3f(x1, -448.f, 448.f), 0, false); \
              pk = __builtin_amdgcn_cvt_pk_fp8_f32(__builtin_amdgcn_fmed3f(x2, -448.f, 448.f), __builtin_amdgcn_fmed3f(x3, -448.f, 448.f), pk, true); \
              *(LAS unsigned*)(uintptr_t)(unsigned)(xs + 4 * lane) = (unsigned)pk; } \
              \
            const u32x4 b00 = *(LAS u32x4*)(uintptr_t)(unsigned)(xs + 16 * g), b01 = *(LAS u32x4*)(uintptr_t)(unsigned)(xs + 64 + 16 * g); \
            const u32x4 b10 = *(LAS u32x4*)(uintptr_t)(unsigned)(xs + 128 + 16 * g), b11 = *(LAS u32x4*)(uintptr_t)(unsigned)(xs + 192 + 16 * g); \
            const i32x8 bq0 = {(int)b00.x, (int)b00.y, (int)b00.z, (int)b00.w, (int)b01.x, (int)b01.y, (int)b01.z, (int)b01.w}; \
            const i32x8 bq1 = {(int)b10.x, (int)b10.y, (int)b10.z, (int)b10.w, (int)b11.x, (int)b11.y, (int)b11.z, (int)b11.w}; \
            f32x4 acc[8]; \
            _Pragma("unroll") for (int be = 0; be < 8; ++be) acc[be] = (f32x4){0.f, 0.f, 0.f, 0.f}; \
            _Pragma("unroll") for (int be = 0; be < 8; ++be) PU_MF(be, ard0, bq0) \
            _Pragma("unroll") for (int be = 0; be < 8; ++be) PU_MF(be, ard1, bq1) \
            f32x4 o_ = acc[0]; \
            _Pragma("unroll") for (int be = 1; be < 8; ++be) { const bool m_ = (i16 == be); o_[0] = m_ ? acc[be][0] : o_[0]; o_[1] = m_ ? acc[be][1] : o_[1]; o_[2] = m_ ? acc[be][2] : o_[2]; o_[3] = m_ ? acc[be][3] : o_[3]; } \
            __builtin_amdgcn_raw_buffer_store_b128((u32x4){__float_as_uint(o_[0]), __float_as_uint(o_[1]), __float_as_uint(o_[2]), __float_as_uint(o_[3])}, prs, \
                                                   (i16 < 8 && (valid)) ? (((t) * NSL4 + s) * PE + 16 * i16 + 4 * g) * 4 : 0x7ffffff0, 0, 0);        \
            asm volatile("s_waitcnt lgkmcnt(0)" ::: "memory"); } while (0)
        PU_ISSUE(rA, xA, pl.lw, idwA, idwB);
        for (int t = pl.lw; t < TOK; t += 2 * pl.nlw) {
            const bool vB = t + pl.nlw < TOK; const int tB = vB ? t + pl.nlw : t, tA2 = (t + 2 * pl.nlw < TOK) ? t + 2 * pl.nlw : t;
            PU_ISSUE(rB, xB, tB, idwB, idwA);
            PU_COMPUTE(rA, xA, t, true);
            PU_ISSUE(rA, xA, tA2, idwA, idwB);
            PU_COMPUTE(rB, xB, tB, vB);
        }
#undef PU_ISSUE
#undef PU_MF
#undef PU_COMPUTE
    }
}
template <int NSLU, int U4>
__device__ __forceinline__ void phase_r(Frame& F, const float* P) {
    const int lane = F.lane, l32 = lane & 31;
    const float* part = (const float*)(F.ws + WS_PART); const float* gate = (const float*)(F.ws + WS_GSM); float* wout = (float*)(F.ws + WS_HB);
    const int gw = blockIdx.x * NWAVES + F.wave, NGW = F.G * NWAVES;
    for (int t0 = gw; t0 < TOK; t0 += 2 * NGW) {
        const int t1 = (t0 + NGW < TOK) ? t0 + NGW : t0;
        f32x4 v[2][NSLU / 2]; float pp[2]; f32x4 g[2];
#pragma unroll
        for (int u = 0; u < 2; ++u) { const int t = u ? t1 : t0;
            const f32x4* base = (const f32x4*)(P + (size_t)t * NSLU * PE) + lane;
#pragma unroll
            for (int i = 0; i < NSLU / 2; ++i) v[u][i] = base[64 * i];
            pp[u] = lane < 32 ? part[(size_t)t * 32 + lane] : 0.f;
            g[u] = *(const f32x4*)(gate + (size_t)t * PE + l32 * 4); }
#pragma unroll
        for (int u = 0; u < 2; ++u) { const int t = u ? t1 : t0;
            const float rstd = (1.0f / (U4 ? PEER_U4_SCALE : PEER_U_SCALE)) / sqrtf(wave_sum(pp[u]) * (1.0f / DM) + NORM_EPS);
            f32x4 a = v[u][0];
#pragma unroll
            for (int i = 1; i < NSLU / 2; ++i) a += v[u][i];
            a[0] += __shfl_xor(a[0], 32); a[1] += __shfl_xor(a[1], 32); a[2] += __shfl_xor(a[2], 32); a[3] += __shfl_xor(a[3], 32);
            const float vs = 1.0f / PEER_V_SCALE;
            const f32x4 w = {vs * g[u][0] * gelu_tanh(a[0] * rstd), vs * g[u][1] * gelu_tanh(a[1] * rstd), vs * g[u][2] * gelu_tanh(a[2] * rstd), vs * g[u][3] * gelu_tanh(a[3] * rstd)};
            if (lane < 32 && (u == 0 || t1 != t0)) {
                const u32x2 ids = *(const u32x2*)((const unsigned*)(F.ws + WS_IDX) + (size_t)t * (PE / 2) + l32 * 2);
                const unsigned w01 = cvtpk(w[0], w[1]), w23 = cvtpk(w[2], w[3]);
                *(u32x4*)((unsigned*)wout + (size_t)t * PE + l32 * 4) = (u32x4){(w01 << 16) | (ids.x & 0xffffu), (w01 & 0xffff0000u) | (ids.x >> 16), (w23 << 16) | (ids.y & 0xffffu), (w23 & 0xffff0000u) | (ids.y >> 16)};
                { const float ws_ = PEER_V_SCALE * PEER_W_SCALE;
                  int pk = __builtin_amdgcn_cvt_pk_fp8_f32(fminf(fmaxf(w[0] * ws_, -448.f), 448.f), fminf(fmaxf(w[1] * ws_, -448.f), 448.f), 0, false);
                  pk = __builtin_amdgcn_cvt_pk_fp8_f32(fminf(fmaxf(w[2] * ws_, -448.f), 448.f), fminf(fmaxf(w[3] * ws_, -448.f), 448.f), pk, true);
                  *(unsigned*)((unsigned char*)(F.ws + WS_HB + 8 * MiB) + (size_t)t * PE + l32 * 4) = (unsigned)pk; } } }
    }
}
constexpr float PEER_V4_SCALE = 5.656854249f;
__device__ __forceinline__ void phase_v4(Frame& F, const Place& pl, int layer, const bf16* xin, float* xout, bf16* xbout, float* part2) {
    const int lane = F.lane, j = lane >> 3, c = lane & 7, n16 = lane & 15, g = lane >> 4;
    const unsigned char* vb = (const unsigned char*)(F.ws + WS_VB) + (size_t)layer * PEXP * (DM / 2);
    const __amdgpu_buffer_rsrc_t wrs = __builtin_amdgcn_make_buffer_rsrc((void*)(F.ws + WS_HB), 0, TOK * PE * 4, 0x00020000);
    const __amdgpu_buffer_rsrc_t frs = __builtin_amdgcn_make_buffer_rsrc((void*)(F.ws + WS_HB + 8 * MiB), 0, TOK * PE, 0x00020000);
    const __amdgpu_buffer_rsrc_t xirs = __builtin_amdgcn_make_buffer_rsrc((void*)xin, 0, TOK * DM * 2, 0x00020000);
    const __amdgpu_buffer_rsrc_t xors = __builtin_amdgcn_make_buffer_rsrc((void*)(xout ? (void*)xout : (void*)xin), 0, xout ? TOK * DM * 4 : 0, 0x00020000);
    const __amdgpu_buffer_rsrc_t xbrs = __builtin_amdgcn_make_buffer_rsrc((void*)(xbout ? (void*)xbout : (void*)xin), 0, xbout ? TOK * DM * 2 : 0, 0x00020000);
    const __amdgpu_buffer_rsrc_t p2rs = __builtin_amdgcn_make_buffer_rsrc((void*)(part2 ? (void*)part2 : (void*)xin), 0, part2 ? TOK * 32 * 4 : 0, 0x00020000);
    const int bsrc = j * 4;
    const int tile = (int)(uintptr_t)((char*)F.lds) + F.wave * 16384;
    const int wr0 = tile + j * 128 + ((c ^ (j >> 1)) * 16), wr1 = tile + j * 128 + ((c ^ (4 + (j >> 1))) * 16);
    const int trb = (tile + (32 * g + n16) * 128) | ((2 * ((n16 >> 1) & 7) + (g & 1)) * 8);
    for (int s = pl.ord; s < NSL4; s += pl.nx) {
        const __amdgpu_buffer_rsrc_t rs = __builtin_amdgcn_make_buffer_rsrc((void*)(vb + (size_t)s * PEXP * SLB4), 0, PEXP * SLB4, 0x00020000);
        u32x4 rA[16], rB[16], wA0, wA1, wB0, wB1; u32x2 resA, resB;
        unsigned cwA0 = __builtin_amdgcn_raw_buffer_load_b32(wrs, (pl.lw * PE + lane) * 4, 0, 0), cwA1 = __builtin_amdgcn_raw_buffer_load_b32(wrs, (pl.lw * PE + 64 + lane) * 4, 0, 0), cwB0 = 0, cwB1 = 0;
#define PV_ISSUE(r, w0, w1, res, t, cw0, cw1, cn0, cn1) do { __builtin_amdgcn_sched_barrier(0); \
            { const int tn_ = ((t) + pl.nlw < TOK) ? (t) + pl.nlw : (t); cn0 = __builtin_amdgcn_raw_buffer_load_b32(wrs, (tn_ * PE + lane) * 4, 0, 0); cn1 = __builtin_amdgcn_raw_buffer_load_b32(wrs, (tn_ * PE + 64 + lane) * 4, 0, 0); } asm volatile("" ::: "memory"); \
            _Pragma("unroll") for (int b = 0; b < 16; ++b) { const unsigned cwp_ = (unsigned)__builtin_amdgcn_ds_bpermute(bsrc + 32 * (b & 7), (int)(b < 8 ? cw0 : cw1)); \
                r[b] = __builtin_amdgcn_raw_buffer_load_b128(rs, (int)(cwp_ & 0xffffu) * SLB4 + c * 16, 0, 0); } \
            w0 = __builtin_amdgcn_raw_buffer_load_b128(frs, (t) * PE + 16 * g, 0, 0); w1 = __builtin_amdgcn_raw_buffer_load_b128(frs, (t) * PE + 64 + 16 * g, 0, 0); \
            res = __builtin_amdgcn_raw_buffer_load_b64(xirs, ((t) * DM + s * SLW4 + 64 * g + 4 * n16) * 2, 0, 0); \
            asm volatile("" ::: "memory"); __builtin_amdgcn_sched_barrier(0); } while (0)
#define PV_TR(cb, hf, dst) asm volatile("ds_read_b64_tr_b4 %0, %1 offset:%2" : "=&v"(dst) : "v"(trb_ ^ ((cb) * 8)), "i"((hf) * 2048) : "memory")
#define PV_MF(k, lo, hi) acc[k] = __builtin_amdgcn_mfma_scale_f32_16x16x128_f8f6f4(aw_, (i32x8){(int)lo[0], (int)lo[1], (int)hi[0], (int)hi[1], 0, 0, 0, 0}, acc[k], 0, 4, 0, 0x7f7f7f7f, 0, 0x7f7f7f7f)
#define PV_HALF(hh, s0_, s1_) { s0_ = 0.f; s1_ = 0.f; \
            _Pragma("unroll") for (int kk = 0; kk < 2; ++kk) { u32x2 l0, h0, l1, h1, l2, h2, l3, h3; f32x4 acc[4]; \
                _Pragma("unroll") for (int k = 0; k < 4; ++k) acc[k] = (f32x4){0.f, 0.f, 0.f, 0.f}; \
                PV_TR(8 * hh + 4 * kk + 0, 0, l0); PV_TR(8 * hh + 4 * kk + 0, 1, h0); PV_TR(8 * hh + 4 * kk + 1, 0, l1); PV_TR(8 * hh + 4 * kk + 1, 1, h1); \
                PV_TR(8 * hh + 4 * kk + 2, 0, l2); PV_TR(8 * hh + 4 * kk + 2, 1, h2); PV_TR(8 * hh + 4 * kk + 3, 0, l3); PV_TR(8 * hh + 4 * kk + 3, 1, h3); \
                asm volatile("s_waitcnt lgkmcnt(0)" ::: "memory"); SBAR(); \
                PV_MF(0, l0, h0); PV_MF(1, l1, h1); PV_MF(2, l2, h2); PV_MF(3, l3, h3); \
                asm volatile("" : "+v"(acc[0][0]), "+v"(acc[1][0]), "+v"(acc[2][0]), "+v"(acc[3][0]) : "v"(l0), "v"(h0), "v"(l1), "v"(h1), "v"(l2), "v"(h2), "v"(l3), "v"(h3)); \
                s0_ = (g == 2 * kk) ? acc[0][0] : s0_; s1_ = (g == 2 * kk) ? acc[1][0] : s1_; s0_ = (g == 2 * kk + 1) ? acc[2][0] : s0_; s1_ = (g == 2 * kk + 1) ? acc[3][0] : s1_; } }
#define PV_COMPUTE(r, w0, w1, res, t, valid) do { \
            _Pragma("unroll") for (int b = 0; b < 16; ++b) { const int ad_ = ((b & 1) ? wr1 : wr0) + 1024 * b; \
                if ((b >> 2) & 1) { *(LAS u32x2*)(uintptr_t)(unsigned)(ad_ + 8) = (u32x2){r[b].x, r[b].y}; *(LAS u32x2*)(uintptr_t)(unsigned)(ad_) = (u32x2){r[b].z, r[b].w}; } \
                else *(LAS u32x4*)(uintptr_t)(unsigned)(ad_) = r[b]; } \
            asm volatile("s_waitcnt lgkmcnt(0)" ::: "memory"); \
            int trb_ = trb; asm volatile("" : "+v"(trb_));            \
            const i32x8 aw_ = {(int)w0.x, (int)w0.y, (int)w0.z, (int)w0.w, (int)w1.x, (int)w1.y, (int)w1.z, (int)w1.w}; \
            float q0, q1, q2, q3; \
            PV_HALF(0, q0, q1) PV_HALF(1, q2, q3) \
            const float sc_ = 1.0f / (PEER_V4_SCALE * PEER_W_SCALE); \
              \
            const float v0 = fmaf(q0, sc_, __uint_as_float(res.x << 16)), v1 = fmaf(q1, sc_, __uint_as_float(res.x & 0xffff0000u)), v2 = fmaf(q2, sc_, __uint_as_float(res.y << 16)), v3 = fmaf(q3, sc_, __uint_as_float(res.y & 0xffff0000u)); \
            const int o_ = (valid) ? (t) * DM + s * SLW4 + 64 * g + 4 * n16 : 0x0ffffff0; \
            __builtin_amdgcn_raw_buffer_store_b128((u32x4){__float_as_uint(v0), __float_as_uint(v1), __float_as_uint(v2), __float_as_uint(v3)}, xors, o_ * 4, 0, 0); \
            __builtin_amdgcn_raw_buffer_store_b64((u32x2){cvtpk(v0, v1), cvtpk(v2, v3)}, xbrs, o_ * 2, 0, 0); \
            if (part2) { const float ss = wave_sum((v0 * v0 + v1 * v1) + (v2 * v2 + v3 * v3)); \
                __builtin_amdgcn_raw_buffer_store_b32(__float_as_uint(lane == 0 ? ss : 0.f), p2rs, (lane < 4 && (valid)) ? ((t) * 32 + s + 8 * lane) * 4 : 0x7ffffff0, 0, 0); } \
            asm volatile("s_waitcnt lgkmcnt(0)" ::: "memory"); } while (0)
        PV_ISSUE(rA, wA0, wA1, resA, pl.lw, cwA0, cwA1, cwB0, cwB1);
        for (int t = pl.lw; t < TOK; t += 2 * pl.nlw) {
            const bool vB = t + pl.nlw < TOK; const int tB = vB ? t + pl.nlw : t, tA2 = (t + 2 * pl.nlw < TOK) ? t + 2 * pl.nlw : t;
            PV_ISSUE(rB, wB0, wB1, resB, tB, cwB0, cwB1, cwA0, cwA1);
            PV_COMPUTE(rA, wA0, wA1, resA, t, true);
            PV_ISSUE(rA, wA0, wA1, resA, tA2, cwA0, cwA1, cwB0, cwB1);
            PV_COMPUTE(rB, wB0, wB1, resB, tB, vB);
        }
#undef PV_ISSUE
#undef PV_TR
#undef PV_MF
#undef PV_HALF
#undef PV_COMPUTE
    }
}
}
#ifndef REP_MASK
#define REP_MASK 0
#endif
#if REP_MASK == 0
#define REPS(i) if (constexpr int rep_ = 0; true)
#else
#define REPS(i) for (int rep_ = 0; rep_ < 1 + ((REP_MASK >> (i)) & 1); ++rep_)
#endif
#ifndef DBG_STAGE
#define DBG_STAGE 0
#endif
struct Args { const float* in[16]; float* out; unsigned char* ws; int pad0, pad1; };
__global__ void __launch_bounds__(NTHREADS, 2) fwd_megakernel(Args args) {
    extern __shared__ __attribute__((aligned(16))) unsigned char lds[];
    cg::grid_group grid = cg::this_grid();
    Frame F;
    F.lds = (LAS unsigned char*)lds;
    F.MISC = (volatile LAS unsigned*)(F.lds + MISC_OFF);
    F.tid = threadIdx.x; F.lane = F.tid & 63; F.wave = __builtin_amdgcn_readfirstlane(F.tid >> 6);
    F.G = gridDim.x; F.ws = (GAS unsigned char*)args.ws; F.out = (GAS float*)args.out;
#pragma unroll
    for (int i = 0; i < 16; ++i) F.in[i] = (const GAS float*)args.in[i];
    F.ctl = (gu32*)((GAS unsigned char*)args.ws + WS_CTL);
    for (int u = F.tid; u < (LDS_BYTES - LDSCTL_OFF) / 4; u += NTHREADS) ((LAS unsigned*)(F.lds + LDSCTL_OFF))[u] = 0u;
    __syncthreads();
    XcdBarrier bar = xcd_barrier_post((unsigned*)(F.ctl + CW_BAR), F.MISC + 8);
    if (F.tid == 0) F.MISC[10] = xb_add((unsigned*)(F.ctl + CW_RANK + 64 * bar.x), 1u);
#define GRID_BAR() do { xcd_barrier(bar); PHASE_BEGIN(); } while (0)
#define PLACE() pg::Place{(int)F.MISC[12], (int)F.MISC[11], (int)F.MISC[10] * NWAVES + F.wave, (int)F.MISC[13] * NWAVES}
#define PBUF ((float*)(ws + WS_PROJ))
#define PHASE_BEGIN() do { const int t_ = opaque_tid(); F.tid = t_; F.lane = t_ & 63; F.wave = __builtin_amdgcn_readfirstlane(t_ >> 6); GAS unsigned char* w_ = (GAS unsigned char*)args.ws; asm volatile("" : "+s"(w_)); ws = w_; F.ws = ws; } while (0)
    GAS unsigned char* ws = (GAS unsigned char*)args.ws;
#define XB0 ((bf16*)(ws + WS_XB0))
#define XB1 ((bf16*)(ws + WS_XB1))
#define XR ((float*)(ws + WS_XR))
#define PROJ ((bf16*)(ws + WS_PROJ))
#define PQ ((bf16*)(ws + WS_HS))
#define HB ((bf16*)(ws + WS_HB))
#define PART ((float*)(ws + WS_PART))
#define rstd0 ((float*)(ws + WS_RSTD))
#define rstd2 ((float*)(ws + WS_RSTD) + TOK)
    const int bid = (int)blockIdx.x;
    constexpr int STG = DBG_STAGE;

    REPS(0) { p0_prologue(F); VM_WAIT(); __syncthreads(); if (rep_ == 0) grid.sync(); else xcd_barrier(bar); PHASE_BEGIN(); }
    if (F.tid == 0) {
        unsigned nx = 0, ord = 0, nloc = 1;
        for (unsigned j = 0; j < 16; ++j) { const unsigned cnt = xb_ld((unsigned*)(F.ctl + CW_BAR) + XB_XCNT(j)); if (cnt) { if (j < bar.x) ++ord; ++nx; } if (j == bar.x) nloc = cnt ? cnt : 1; }
        F.MISC[11] = nx ? nx : 1; F.MISC[12] = ord; F.MISC[13] = nloc;
    }
    __syncthreads();
    if (STG >= 0) {
REPS(1) {
        if (bid < 64) ml::scan(F, bid >> 1, bid & 1);
    {
        pg8::Gemm g{XB0, (const bf16*)(ws + WS_WIN), TOK, MPROJ, DM}; pg8::StaticOrder S; S.init(TOK, MPROJ, F.G, bid);
        pg8::EpiScaleBf16 E{PROJ, MPROJ, rstd0, 4096};
        pg8::gemm_phase<pg8::EpiScaleBf16, pg8::StaticOrder, PG8_ALIGN, PG8_SP2>(F.lds, g, S, E);
    }
    GRID_BAR();
    }
#ifdef REP_BAR
    for (int rb_ = 0; rb_ < REP_BAR; ++rb_) GRID_BAR();
#endif
REPS(2) {
        ml2::phase<0>(F);
#ifdef ML_PROBE
        xcd_barrier(bar); PHASE_BEGIN(); ml2::phase<ML_PROBE + 1>(F);
#endif
    GRID_BAR();
    }
REPS(4) {
        {
        pg8::Gemm g{HB, (const bf16*)(ws + WS_WOUT), TOK, DM, DM}; pg8::StaticOrder S; S.init(TOK, DM, F.G, bid);
        pg8::EpiResidT<false, STG == 1> E{(const void*)F.in[0], XR, XB1, PART, DM};
        pg8::gemm_phase<pg8::EpiResidT<false, STG == 1>, pg8::StaticOrder, PG8_ALIGN, PG8_SP2>(F.lds, g, S, E);
    }
    GRID_BAR();
    }
    if (STG == 0 || STG >= 2) {
REPS(5) {
        {
        pg8::Gemm g{XB1, (const bf16*)(ws + WS_WQ), TOK, DM, DM}; pg8::StaticOrder S; S.init(TOK, DM, F.G, bid);
        pg8::EpiScaleBf16 E{PQ, DM, nullptr, 1 << 30};
        pg8::gemm_phase<pg8::EpiScaleBf16, pg8::StaticOrder, PG8_ALIGN, PG8_SP2>(F.lds, g, S, E);
    }
    GRID_BAR();
    }
REPS(6) {
        tk::phase<0>(F, 0, PQ);
#ifdef TK_PROBE
    xcd_barrier(bar); PHASE_BEGIN(); tk::phase<TK_PROBE + 1>(F, 0, PQ);
#endif
    GRID_BAR();
    }
REPS(7) { const pg::Place pl = PLACE(); pg::phase_u4<0>(F, pl, 0, XB1, PBUF); GRID_BAR(); }
#ifdef PU_PROBE
    { const pg::Place pl = PLACE(); pg::phase_u4<PU_PROBE>(F, pl, 0, XB1, (float*)(ws + WS_PSCR)); GRID_BAR(); }
#endif
    REPS(15) { pg::phase_r<pg::NSL4, 1>(F, PBUF); GRID_BAR(); }
    REPS(16) {
        { const pg::Place pl = PLACE(); pg::phase_v4(F, pl, 0, XB1, nullptr, XB0, PART); }
    GRID_BAR();
    }
    if (STG == 0 || STG >= 3) {
REPS(8) {
        {
        pg8::Gemm g{XB0, (const bf16*)(ws + WS_AIN), TOK, APROJ, DM}; pg8::StaticOrder S; S.init(TOK, APROJ, F.G, bid);
        pg8::EpiScaleBf16 E{PROJ, APROJ, nullptr, 1 << 30};
        pg8::gemm_phase<pg8::EpiScaleBf16, pg8::StaticOrder, PG8_ALIGN, PG8_SP2>(F.lds, g, S, E);
    }
    GRID_BAR();
    }
    at::rope_phase(F);
    GRID_BAR();
REPS(10) {
        at::phase(F);
    GRID_BAR();
    }
REPS(11) {
        {
        pg8::Gemm g{HB, (const bf16*)(ws + WS_AOUT), TOK, DM, DM}; pg8::StaticOrder S; S.init(TOK, DM, F.G, bid);
        pg8::EpiResidT<true, STG == 3> E{(const void*)XB0, XR, XB1, PART, DM};
        pg8::gemm_phase<pg8::EpiResidT<true, STG == 3>, pg8::StaticOrder, PG8_ALIGN, PG8_SP2>(F.lds, g, S, E);
    }
    GRID_BAR();
    }
    if (STG == 0) {
REPS(12) {
        {
        pg8::Gemm g{XB1, (const bf16*)(ws + WS_WQ) + (size_t)DM * DM, TOK, DM, DM}; pg8::StaticOrder S; S.init(TOK, DM, F.G, bid);
        pg8::EpiScaleBf16 E{PQ, DM, nullptr, 1 << 30};
        pg8::gemm_phase<pg8::EpiScaleBf16, pg8::StaticOrder, PG8_ALIGN, PG8_SP2>(F.lds, g, S, E);
    }
    GRID_BAR();
    }
REPS(13) {
        tk::phase<0>(F, 1, PQ);
    GRID_BAR();
    }
    REPS(14) { const pg::Place pl = PLACE(); pg::phase_u4<0>(F, pl, 1, XB1, PBUF); GRID_BAR(); }
    REPS(17) { pg::phase_r<pg::NSL4, 1>(F, PBUF); GRID_BAR(); }
    REPS(18) { { const pg::Place pl = PLACE(); pg::phase_v4(F, pl, 1, XB1, (float*)F.out, nullptr, nullptr); } if (rep_ + 1 < 1 + ((REP_MASK >> 18) & 1)) GRID_BAR(); }
    }
    }
    }
    }
#if DBG_STAGE == 1 || DBG_STAGE == 3 || DBG_STAGE == -1
    {
        const float* src = (DBG_STAGE == -1) ? (const float*)F.in[0] : (const float*)XR;
        const size_t gtid = (size_t)blockIdx.x * NTHREADS + F.tid, gthreads = (size_t)F.G * NTHREADS;
        for (size_t i = gtid; i < (size_t)TOK * DM / 4; i += gthreads) ((f32x4*)F.out)[i] = ((const f32x4*)src)[i];
    }
#endif
}

extern "C" void kernel_launch(void* const* d_in, const int* in_sizes, int n_in, void* d_out, int out_size, void* d_ws, size_t ws_size, hipStream_t stream) {
    static int grid = 0;
    if (grid == 0) {
        if (n_in != 16 || in_sizes[0] != TOK * DM || out_size != TOK * DM || ws_size < WS_END) {
            fprintf(stderr, "kernel_launch: unexpected shapes: n_in %d in0 %d out %d ws %zu (need >= %zu)\n", n_in, n_in > 0 ? in_sizes[0] : -1, out_size, ws_size, (size_t)WS_END); grid = -1; return; }
        int dev = 0, cus = 0, per_cu = 0;
        if (hipGetDevice(&dev) != hipSuccess || hipDeviceGetAttribute(&cus, hipDeviceAttributeMultiprocessorCount, dev) != hipSuccess) { fprintf(stderr, "kernel_launch: device query failed\n"); grid = -1; return; }
        if (hipFuncSetAttribute((const void*)fwd_megakernel, hipFuncAttributeMaxDynamicSharedMemorySize, LDS_BYTES) != hipSuccess) { fprintf(stderr, "kernel_launch: hipFuncSetAttribute failed\n"); grid = -1; return; }
        if (hipOccupancyMaxActiveBlocksPerMultiprocessor(&per_cu, (const void*)fwd_megakernel, NTHREADS, LDS_BYTES) != hipSuccess || per_cu < 1) {
            fprintf(stderr, "kernel_launch: occupancy query reports %d workgroups per CU\n", per_cu); (void)hipGetLastError(); per_cu = 1; }
        grid = cus;
        fprintf(stderr, "kernel_launch: %d CUs, occupancy %d per CU, grid %d\n", cus, per_cu, grid);
    }
    if (grid < 0) return;
    if (hipMemsetAsync((char*)d_ws + WS_CTL, 0, CTL_ZERO_BYTES, stream) != hipSuccess) { fprintf(stderr, "kernel_launch: memset failed\n"); return; }
    Args a{};
    for (int i = 0; i < 16; ++i) a.in[i] = (const float*)d_in[i];
    a.out = (float*)d_out; a.ws = (unsigned char*)d_ws;
    void* kargs[] = {&a};
    const hipError_t e = hipLaunchCooperativeKernel((const void*)fwd_megakernel, dim3(grid), dim3(NTHREADS), kargs, LDS_BYTES, stream);
    if (e != hipSuccess) fprintf(stderr, "kernel_launch: cooperative launch failed: %s (grid %d)\n", hipGetErrorString(e), grid);
}
```

```cpp
#include <hip/hip_runtime.h>
#include <hip/hip_cooperative_groups.h>
#include <cstdio>
#include <cstdint>
namespace cg = cooperative_groups;
namespace pg8 {
#define PG8_LAS __attribute__((address_space(3)))
typedef unsigned short bf16_t;
typedef short bf16x8 __attribute__((ext_vector_type(8)));
typedef float f32x4 __attribute__((ext_vector_type(4)));
typedef unsigned u32x4 __attribute__((ext_vector_type(4)));
constexpr int BM = 256, BK = 64, HALF = 128, HTB = HALF * BK * 2  , STAGE_BYTES = 8 * HTB, NXCD = 8, WGM = 8;

__host__ __device__ __forceinline__ int lds_byte(int r, int c) { const int st = (r >> 4) * 2 + (c >> 5), rr = r & 15, cc = c & 31, ob = rr * 64 + cc * 2; return st * 1024 + (ob ^ (((ob >> 9) & 1) << 5)); }
__host__ __device__ __forceinline__ void stage_rc(int b, int& R, int& C) { const int st = b / 1024, sb = b % 1024, swz = sb ^ (((sb >> 9) & 1) << 5); R = (st >> 1) * 16 + swz / 64; C = (st & 1) * 32 + (swz % 64) / 2; }
__host__ __device__ __forceinline__ int perm32(int rho) { const int n = rho >> 4, i = rho & 15; return 8 * (i >> 2) + 4 * n + (i & 3); }

struct Unit { int pm, pn; };
struct Gemm { const bf16_t* A; const bf16_t* Bt; int M, N, K; };

struct StaticOrder {
    int nM, nN, nwg, G, c;
    __host__ __device__ void init(int M, int N, int G_, int c_) { nM = M / BM; nN = N / BM; nwg = nM * nN; G = G_; c = c_; }
    __host__ __device__ bool next(int i, Unit& u) const {
        const long L = (long)i * G + c; if (L >= nwg) return false;
        int wgid = (int)L; { const int q = nwg / NXCD, r = nwg % NXCD, xcd = wgid % NXCD, off = wgid / NXCD; wgid = (xcd < r ? xcd * (q + 1) : r * (q + 1) + (xcd - r) * q) + off; }
        const int nig = WGM * nN, gid = wgid / nig, fm = gid * WGM, gsz = (nM - fm) < WGM ? (nM - fm) : WGM;
        u.pm = fm + ((wgid % nig) % gsz); u.pn = (wgid % nig) / gsz; return true;
    }
    __device__ __forceinline__ void a_ready(const Unit&) const {}
    __device__ __forceinline__ void done(const Unit&) const {}
};

__device__ __forceinline__ unsigned cvt_pk_bf16(float lo, float hi) { unsigned r; asm volatile("v_cvt_pk_bf16_f32 %0, %1, %2" : "=v"(r) : "v"(lo), "v"(hi)); return r; }
__device__ __forceinline__ float sigmoid_f(float x) { return __builtin_amdgcn_rcpf(1.0f + __expf(-x)); }
struct EpiScaleBf16 {
    static constexpr bool PERM = true, AFTER_DRAIN = false;
    bf16_t* O; int ldc; const float* rs; int sig_from;
    __device__ __forceinline__ void operator()(const f32x4 (&acc)[2][2][4][2], const Unit& u, int wr, int wc, int fr, int fq) const {
        const int row0 = u.pm * BM + wr * 64 + fr; const int col0 = u.pn * BM + wc * 32 + 8 * fq;
        const bool sg = (u.pn * BM) >= sig_from;
#pragma unroll
        for (int ai = 0; ai < 2; ++ai)
#pragma unroll
            for (int m = 0; m < 4; ++m) { const int r = row0 + ai * HALF + m * 16; const float s = rs ? rs[r] : 1.0f; bf16_t* rowp = O + (size_t)r * ldc + col0;
#pragma unroll
                for (int bj = 0; bj < 2; ++bj) { f32x4 v0 = acc[ai][bj][m][0] * s, v1 = acc[ai][bj][m][1] * s;
                    if (sg) { v0 = (f32x4){sigmoid_f(v0[0]), sigmoid_f(v0[1]), sigmoid_f(v0[2]), sigmoid_f(v0[3])}; v1 = (f32x4){sigmoid_f(v1[0]), sigmoid_f(v1[1]), sigmoid_f(v1[2]), sigmoid_f(v1[3])}; }
                    u32x4 w; w.x = cvt_pk_bf16(v0[0], v0[1]); w.y = cvt_pk_bf16(v0[2], v0[3]); w.z = cvt_pk_bf16(v1[0], v1[1]); w.w = cvt_pk_bf16(v1[2], v1[3]);
                    *(u32x4*)(rowp + bj * HALF) = w; } }
    }
};
template <bool BASE_BF, bool F32OUT>
struct EpiResidT {
    static constexpr bool PERM = false, AFTER_DRAIN = false;
    const void* base; float* out; bf16_t* xb; float* part; int ldc;
    __device__ __forceinline__ void operator()(const f32x4 (&acc)[2][2][4][2], const Unit& u, int wr, int wc, int fr, int fq) const {
        typedef unsigned u32x2v __attribute__((ext_vector_type(2)));
        const int row0 = u.pm * BM + wr * 64 + fr; const int col0 = u.pn * BM + wc * 32 + 4 * fq;
#pragma unroll
        for (int ai = 0; ai < 2; ++ai)
#pragma unroll
            for (int m = 0; m < 4; ++m) { const int r = row0 + ai * HALF + m * 16; const size_t off = (size_t)r * ldc + col0; float ss = 0.f;
#pragma unroll
                for (int bj = 0; bj < 2; ++bj)
#pragma unroll
                    for (int n = 0; n < 2; ++n) { f32x4 b;
                        if (BASE_BF) { const u32x2v q = *(const u32x2v*)((const bf16_t*)base + off + bj * HALF + n * 16);
                            b = (f32x4){__uint_as_float(q.x << 16), __uint_as_float(q.x & 0xffff0000u), __uint_as_float(q.y << 16), __uint_as_float(q.y & 0xffff0000u)}; }
                        else b = *(const f32x4*)((const float*)base + off + bj * HALF + n * 16);
                        const f32x4 o = b + acc[ai][bj][m][n];
                        if (F32OUT) *(f32x4*)(out + off + bj * HALF + n * 16) = o;
                        u32x2v w; w.x = cvt_pk_bf16(o[0], o[1]); w.y = cvt_pk_bf16(o[2], o[3]);
                        *(u32x2v*)(xb + off + bj * HALF + n * 16) = w; ss += (o[0] * o[0] + o[1] * o[1]) + (o[2] * o[2] + o[3] * o[3]); }
                ss += __shfl_xor(ss, 16); ss += __shfl_xor(ss, 32);
                if (fq == 0) part[(size_t)r * 32 + u.pn * 4 + wc] = ss;
                if (m & 1) asm volatile("" ::: "memory"); }
    }
};
template <class Epi, class Sched, bool ALIGN_EPI = false, bool SP2 = false>
__device__ __forceinline__ void gemm_phase(PG8_LAS unsigned char* lds, const Gemm g, const Sched& S, const Epi& E) {
    int tid = threadIdx.x; asm volatile("" : "+v"(tid)); const int wid = __builtin_amdgcn_readfirstlane(tid >> 6), lane = tid & 63, wr = wid >> 2, wc = wid & 3, fr = lane & 15, fq = lane >> 4;
    const int K = g.K, nt = K / BK;
    unsigned voffA[2], voffB[2];
#pragma unroll
    for (int i = 0; i < 2; ++i) { int R, C; stage_rc(tid * 16 + i * 8192, R, C); const int Rb = Epi::PERM ? ((R & ~31) + perm32(R & 31)) : R;
        voffA[i] = (unsigned)(R * K + C) * 2u; voffB[i] = (unsigned)(Rb * K + C) * 2u; }
    const size_t kstep = (size_t)(BK * 2);
    const size_t hstep = (size_t)HALF * K * 2;
    const size_t tstep = 2 * hstep;
    const unsigned ldsw = (unsigned)wid * 1024u;
    const int aoff = lds_byte(wr * 64 + fr, fq * 8), boff = lds_byte(wc * 32 + fr, fq * 8);
#define PG8_SA(b, h) (((b) * 2 + (h)) * HTB)
#define PG8_SB(b, h) ((4 + (b) * 2 + (h)) * HTB)
#define PG8_STAGE(bufoff, gbase, voff) do { _Pragma("unroll") for (int _i = 0; _i < 2; ++_i) \
        __builtin_amdgcn_global_load_lds((const unsigned*)((const char*)(gbase) + (voff)[_i]), (PG8_LAS unsigned*)(lds + (bufoff) + ldsw + _i * 8192), 16, 0, 0); } while (0)
#define PG8_LDA(dst, b, h) do { _Pragma("unroll") for (int m = 0; m < 4; ++m) _Pragma("unroll") for (int k = 0; k < 2; ++k) dst[m][k] = *(const PG8_LAS bf16x8*)(lds + PG8_SA(b, h) + aoff + m * 2048 + k * 1024); } while (0)
#define PG8_LDB(dst, b, h) do { _Pragma("unroll") for (int n = 0; n < 2; ++n) _Pragma("unroll") for (int k = 0; k < 2; ++k) dst[n][k] = *(const PG8_LAS bf16x8*)(lds + PG8_SB(b, h) + boff + n * 2048 + k * 1024); } while (0)
#define PG8_MMA(ai, bj, At, Bt) do { __builtin_amdgcn_s_setprio(1); _Pragma("unroll") for (int m = 0; m < 4; ++m) _Pragma("unroll") for (int n = 0; n < 2; ++n) _Pragma("unroll") for (int k = 0; k < 2; ++k) \
        acc[ai][bj][m][n] = __builtin_amdgcn_mfma_f32_16x16x32_bf16(Bt[n][k], At[m][k], acc[ai][bj][m][n], 0, 0, 0); __builtin_amdgcn_s_setprio(0); } while (0)
#define PG8_WAIT_V(n) asm volatile("s_waitcnt vmcnt(" #n ")" ::: "memory")
#define PG8_WAIT_L(n) asm volatile("s_waitcnt lgkmcnt(" #n ")" ::: "memory")
#define PG8_BAR __builtin_amdgcn_s_barrier()
#define PG8_SCHED __builtin_amdgcn_sched_barrier(0)
    Unit cur, nxt; int ui = 0;
    if (!S.next(0, cur)) return;
    f32x4 acc[2][2][4][2];
#pragma unroll
    for (int a = 0; a < 2; ++a)
#pragma unroll
        for (int b = 0; b < 2; ++b)
#pragma unroll
            for (int m = 0; m < 4; ++m)
#pragma unroll
                for (int n = 0; n < 2; ++n) acc[a][b][m][n] = (f32x4){0.f, 0.f, 0.f, 0.f};
    bf16x8 At[4][2], B0[2][2], B1[2][2];
    const char* cA = (const char*)g.A + (size_t)cur.pm * tstep; const char* cB = (const char*)g.Bt + (size_t)cur.pn * tstep;
    S.a_ready(cur);
    if constexpr (SP2) {
        PG8_STAGE(PG8_SB(0, 0), cB, voffB); PG8_STAGE(PG8_SB(0, 1), cB + hstep, voffB); PG8_STAGE(PG8_SA(0, 0), cA, voffA); PG8_STAGE(PG8_SA(0, 1), cA + hstep, voffA);
        if (wr == 1) PG8_BAR;
        PG8_WAIT_V(2); PG8_BAR;
        PG8_STAGE(PG8_SB(1, 0), cB + kstep, voffB); PG8_STAGE(PG8_SA(1, 0), cA + kstep, voffA); PG8_STAGE(PG8_SB(1, 1), cB + hstep + kstep, voffB);
        PG8_WAIT_V(6); PG8_BAR;
    } else {
        PG8_STAGE(PG8_SB(0, 0), cB, voffB); PG8_STAGE(PG8_SA(0, 0), cA, voffA); PG8_STAGE(PG8_SB(0, 1), cB + hstep, voffB); PG8_STAGE(PG8_SA(0, 1), cA + hstep, voffA);
        if (wr == 1) PG8_BAR;
        PG8_WAIT_V(4); PG8_BAR;
        PG8_STAGE(PG8_SB(1, 0), cB + kstep, voffB); PG8_STAGE(PG8_SA(1, 0), cA + kstep, voffA); PG8_STAGE(PG8_SB(1, 1), cB + hstep + kstep, voffB);
        PG8_WAIT_V(6); PG8_BAR;
    }
    for (;;) {
        const bool has_next = S.next(ui + 1, nxt);
        const char* nA = has_next ? (const char*)g.A + (size_t)nxt.pm * tstep : cA; const char* nB = has_next ? (const char*)g.Bt + (size_t)nxt.pn * tstep : cB;
        for (int t = 0; t < nt; t += 2) {
            const bool last = (t == nt - 2);
            const char* a1 = cA + (size_t)(t + 1) * kstep;
            const char* a2 = last ? nA : cA + (size_t)(t + 2) * kstep; const char* b2 = last ? nB : cB + (size_t)(t + 2) * kstep;
            const char* a3 = a2 + kstep; const char* b3 = b2 + kstep;
            if (last && has_next) S.a_ready(nxt);
            if constexpr (SP2) {
            PG8_LDB(B0, 0, 0); PG8_LDB(B1, 0, 1); PG8_SCHED; PG8_LDA(At, 0, 0); PG8_STAGE(PG8_SA(1, 1), a1 + hstep, voffA);
            PG8_WAIT_V(8); PG8_WAIT_L(0); PG8_BAR; PG8_MMA(0, 0, At, B0); PG8_MMA(0, 1, At, B1); PG8_BAR; PG8_SCHED;
            PG8_LDA(At, 0, 1); PG8_STAGE(PG8_SB(0, 0), b2, voffB); PG8_STAGE(PG8_SB(0, 1), b2 + hstep, voffB); PG8_STAGE(PG8_SA(0, 0), a2, voffA);
            PG8_WAIT_V(8); PG8_WAIT_L(0); PG8_BAR; PG8_MMA(1, 0, At, B0); PG8_MMA(1, 1, At, B1); PG8_BAR; PG8_SCHED;
            PG8_LDB(B0, 1, 0); PG8_LDB(B1, 1, 1); PG8_SCHED; PG8_LDA(At, 1, 0); PG8_STAGE(PG8_SA(0, 1), a2 + hstep, voffA);
            PG8_WAIT_V(8); PG8_WAIT_L(0); PG8_BAR; PG8_MMA(0, 0, At, B0); PG8_MMA(0, 1, At, B1); PG8_BAR; PG8_SCHED;
            PG8_LDA(At, 1, 1); PG8_STAGE(PG8_SB(1, 0), b3, voffB); PG8_STAGE(PG8_SB(1, 1), b3 + hstep, voffB); PG8_STAGE(PG8_SA(1, 0), a3, voffA);
            PG8_WAIT_V(8); PG8_WAIT_L(0); PG8_BAR; PG8_MMA(1, 0, At, B0); PG8_MMA(1, 1, At, B1); PG8_BAR; PG8_SCHED;
            } else {
            PG8_LDB(B0, 0, 0); PG8_SCHED; PG8_LDA(At, 0, 0); PG8_STAGE(PG8_SA(1, 1), a1 + hstep, voffA);
            PG8_WAIT_L(8); PG8_BAR; PG8_WAIT_L(0); PG8_MMA(0, 0, At, B0); PG8_BAR; PG8_SCHED;
            PG8_LDB(B1, 0, 1); PG8_STAGE(PG8_SB(0, 0), b2, voffB);
            PG8_BAR; PG8_WAIT_L(0); PG8_MMA(0, 1, At, B1); PG8_BAR;
            PG8_LDA(At, 0, 1); PG8_STAGE(PG8_SA(0, 0), a2, voffA);
            PG8_BAR; PG8_WAIT_L(0); PG8_MMA(1, 0, At, B0); PG8_BAR; PG8_SCHED;
            PG8_STAGE(PG8_SB(0, 1), b2 + hstep, voffB);
            PG8_WAIT_V(6); PG8_BAR; PG8_MMA(1, 1, At, B1); PG8_BAR;
            PG8_LDB(B0, 1, 0); PG8_SCHED; PG8_LDA(At, 1, 0); PG8_STAGE(PG8_SA(0, 1), a2 + hstep, voffA);
            PG8_WAIT_L(8); PG8_BAR; PG8_WAIT_L(0); PG8_MMA(0, 0, At, B0); PG8_BAR; PG8_SCHED;
            PG8_LDB(B1, 1, 1); PG8_STAGE(PG8_SB(1, 0), b3, voffB);
            PG8_BAR; PG8_WAIT_L(0); PG8_MMA(0, 1, At, B1); PG8_BAR;
            PG8_LDA(At, 1, 1); PG8_STAGE(PG8_SA(1, 0), a3, voffA);
            PG8_BAR; PG8_WAIT_L(0); PG8_MMA(1, 0, At, B0); PG8_BAR; PG8_SCHED;
            PG8_STAGE(PG8_SB(1, 1), b3 + hstep, voffB);
            PG8_WAIT_V(6); PG8_BAR; PG8_MMA(1, 1, At, B1); PG8_BAR;
            }
        }
        if constexpr (ALIGN_EPI) { if (wr == 0) PG8_BAR; }
        if constexpr (!Epi::AFTER_DRAIN) { E(acc, cur, wr, wc, fr, fq); S.done(cur); }
        if (!has_next) break;
#pragma unroll
        for (int a = 0; a < 2; ++a)
#pragma unroll
            for (int b = 0; b < 2; ++b)
#pragma unroll
                for (int m = 0; m < 4; ++m)
#pragma unroll
                    for (int n = 0; n < 2; ++n) acc[a][b][m][n] = (f32x4){0.f, 0.f, 0.f, 0.f};
        cur = nxt; cA = nA; cB = nB; ++ui;
        if constexpr (ALIGN_EPI) { if (wr == 1) PG8_BAR; }
    }
    PG8_WAIT_V(0);
    if constexpr (!ALIGN_EPI) { if (wr == 0) PG8_BAR; }
    PG8_BAR;
    if constexpr (Epi::AFTER_DRAIN) { E.fused(acc, cur, wr, wc, fr, fq, lds, wid, lane); S.done(cur); }
#undef PG8_SA
#undef PG8_SB
#undef PG8_STAGE
#undef PG8_LDA
#undef PG8_LDB
#undef PG8_MMA
#undef PG8_WAIT_V
#undef PG8_WAIT_L
#undef PG8_BAR
#undef PG8_SCHED
}
}

#ifndef PG8_SP2
#define PG8_SP2 true
#endif
#ifndef PG8_ALIGN
#define PG8_ALIGN true
#endif
constexpr int NWAVES = 8, NTHREADS = 512;
constexpr int BATCH = 8, SEQ = 2048, DM = 2048, TOK = BATCH * SEQ;
constexpr float NORM_EPS = 1e-6f;
constexpr int MH = 4, MDK = 256, MDV = 512, MLSTM_IN = 6160, MPROJ = 6144;
constexpr int AHQ = 16, AHKV = 4, AD = 128, APROJ = 3072;
constexpr float PEER_U4_SCALE = 90.50966799f;
constexpr float PEER_U_SCALE = 2048.0f, PEER_V_SCALE = 128.0f, PEER_W_SCALE = 64.0f;
constexpr int PHEADS = 8, PKEYS = 128, PTOPK = 16, PHALF = 128, PEXP = 16384, PE = PHEADS * PTOPK;
constexpr size_t MiB = 1u << 20;
constexpr size_t WS_CTL = 0, CTL_ZERO_BYTES = 1 * MiB;
constexpr size_t WS_WIN  = 2 * MiB;
constexpr size_t WS_WOUT = 26 * MiB;
constexpr size_t WS_AIN  = 34 * MiB;
constexpr size_t WS_AOUT = 46 * MiB;
constexpr size_t WS_WQ   = 54 * MiB;
constexpr size_t WS_PK   = 70 * MiB;
constexpr size_t WS_ROPE = 71 * MiB;
constexpr size_t WS_GATE = 72 * MiB;
constexpr size_t WS_SC   = 73 * MiB;
constexpr size_t WS_RSTD = 75 * MiB;
constexpr size_t WS_PART = 76 * MiB;
constexpr size_t WS_IDX  = 78 * MiB;
constexpr size_t WS_GSM  = 86 * MiB;
constexpr size_t WS_XB0  = 96 * MiB;
constexpr size_t WS_XB1  = 160 * MiB;
constexpr size_t WS_XR   = 224 * MiB;
constexpr size_t WS_PROJ = 352 * MiB;
constexpr size_t WS_HS   = 544 * MiB;
constexpr size_t WS_HB   = 608 * MiB;
constexpr size_t WS_UB   = 672 * MiB;
constexpr size_t WS_VB   = 736 * MiB;
constexpr size_t WS_PSCR = 800 * MiB;
constexpr size_t WS_END  = 928 * MiB;
constexpr int CW_BAR = 4096, CW_RANK = 8192;
constexpr int RING_BYTES = 159744;
constexpr int LDSCTL_OFF = RING_BYTES, MISC_OFF = LDSCTL_OFF + 320;
constexpr int LDS_BYTES = 163840;
#define GAS __attribute__((address_space(1)))
#define LAS __attribute__((address_space(3)))
typedef unsigned short bf16;
typedef unsigned gu32;
typedef float f32x4 __attribute__((ext_vector_type(4)));
typedef float f32x2 __attribute__((ext_vector_type(2)));
typedef float f32x16 __attribute__((ext_vector_type(16)));
typedef unsigned u32x4 __attribute__((ext_vector_type(4)));
typedef unsigned u32x2 __attribute__((ext_vector_type(2)));
typedef short bf16x8 __attribute__((ext_vector_type(8)));
typedef short s16x4 __attribute__((ext_vector_type(4)));
#define RLX_AGENT __ATOMIC_RELAXED, __HIP_MEMORY_SCOPE_AGENT
#define LDS_WAIT() asm volatile("s_waitcnt lgkmcnt(0)" ::: "memory")
#define VM_WAIT() asm volatile("s_waitcnt vmcnt(0)" ::: "memory")
#define SBAR() __builtin_amdgcn_sched_barrier(0)
__device__ __forceinline__ unsigned cvtpk(float lo, float hi) { unsigned r; asm volatile("v_cvt_pk_bf16_f32 %0, %1, %2" : "=v"(r) : "v"(lo), "v"(hi)); return r; }
__device__ __forceinline__ float bf_lo(unsigned w) { return __uint_as_float(w << 16); }
__device__ __forceinline__ float bf_hi(unsigned w) { return __uint_as_float(w & 0xffff0000u); }
__device__ __forceinline__ int opaque_tid() { int t = threadIdx.x; asm volatile("" : "+v"(t)); return t; }
__device__ __forceinline__ void assume_global(const void* p) {
#if defined(__HIP_DEVICE_COMPILE__)
    __builtin_assume(!__builtin_amdgcn_is_shared((const __attribute__((address_space(0))) void*)p) && !__builtin_amdgcn_is_private((const __attribute__((address_space(0))) void*)p));
#endif
}
template <int CTRL> __device__ __forceinline__ float dpp_mov(float v) { return __builtin_bit_cast(float, __builtin_amdgcn_update_dpp(0, __builtin_bit_cast(int, v), CTRL, 0xf, 0xf, true)); }
__device__ __forceinline__ float row_sum16(float v) {
    v += dpp_mov<0xB1>(v);
    v += dpp_mov<0x4E>(v);
    v += dpp_mov<0x141>(v);
    v += dpp_mov<0x140>(v);
    return v;
}
__device__ __forceinline__ float wave_sum(float v) {
    v = row_sum16(v);
    const int iv = __builtin_bit_cast(int, v);
    return (__builtin_bit_cast(float, __builtin_amdgcn_readlane(iv, 0)) + __builtin_bit_cast(float, __builtin_amdgcn_readlane(iv, 16)))
         + (__builtin_bit_cast(float, __builtin_amdgcn_readlane(iv, 32)) + __builtin_bit_cast(float, __builtin_amdgcn_readlane(iv, 48)));
}
#define XB_TMO      128
#define XB_XCNT(j)  (256  + 64 * (j))
#define XB_XSUB(j)  (1280 + 64 * (j))
#define XB_XGEN(j)  (2304 + 64 * (j))
#define XB_TOP      3328
#define XB_TOPGEN   3392
#define XCD_BAR_WORDS 3456
#define XB_SPIN_CAP (1u << 20)
__device__ __forceinline__ unsigned xb_ld(unsigned* p)              { return __hip_atomic_load(p, __ATOMIC_RELAXED, __HIP_MEMORY_SCOPE_AGENT); }
__device__ __forceinline__ unsigned xb_add(unsigned* p, unsigned v) { return __hip_atomic_fetch_add(p, v, __ATOMIC_RELAXED, __HIP_MEMORY_SCOPE_AGENT); }
__device__ __forceinline__ unsigned xb_xcc_id() { return (unsigned)__builtin_amdgcn_s_getreg((3 << 11) | 20) & 0xFu; }
#define XB_SPIN(cond, bar) do { unsigned _sp = 0; while (cond) { __builtin_amdgcn_s_sleep(1); \
    if ((++_sp & 255u) == 0u) { if (xb_ld(&(bar)[XB_TMO])) break; if (_sp > XB_SPIN_CAP) { atomicAdd(&(bar)[XB_TMO], 1u); break; } } } } while (0)
struct XcdBarrier { unsigned* bar; unsigned x; volatile LAS unsigned* st; };
__device__ __forceinline__ XcdBarrier xcd_barrier_post(unsigned* bar, volatile LAS unsigned* st) {
    XcdBarrier b; b.bar = bar; b.x = xb_xcc_id(); b.st = st;
    if (threadIdx.x == 0) (void)xb_add(&bar[XB_XCNT(b.x)], 1u);
    return b;
}
__device__ __forceinline__ void xcd_barrier_complete(unsigned* bar, unsigned x, unsigned& nloc, unsigned& nx) {
    const unsigned G = gridDim.x * gridDim.y * gridDim.z;
    unsigned sum, cnt, mine, sp = 0u;
    for (;;) {
        sum = 0u; cnt = 0u; mine = 0u;
#pragma unroll
        for (unsigned j = 0; j < 16; ++j) { const unsigned c = xb_ld(&bar[XB_XCNT(j)]); sum += c; cnt += (c > 0u) ? 1u : 0u; mine = (j == x) ? c : mine; }
        if (sum == G) break;
        __builtin_amdgcn_s_sleep(1);
        if ((++sp & 255u) == 0u) { if (xb_ld(&bar[XB_TMO])) break; if (sp > XB_SPIN_CAP) { atomicAdd(&bar[XB_TMO], 1u); break; } }
    }
    nloc = mine > 0u ? mine : 1u; nx = cnt > 0u ? cnt : 1u;
}
__device__ __forceinline__ void xcd_barrier(const XcdBarrier& b) {
    asm volatile("s_waitcnt vmcnt(0)" ::: "memory");
    __syncthreads();
    if (threadIdx.x == 0) {
        unsigned* bar = b.bar;
        __builtin_amdgcn_s_waitcnt(0);
        unsigned nloc = b.st[0], nx = b.st[1];
        if (nloc == 0u) { xcd_barrier_complete(bar, b.x, nloc, nx); b.st[0] = nloc; b.st[1] = nx; }
        const unsigned old = xb_add(&bar[XB_XSUB(b.x)], 1u);
        const unsigned gen = old / nloc;
        if (old + 1u == (gen + 1u) * nloc) {
            __builtin_amdgcn_fence(__ATOMIC_RELEASE, "agent");
            asm volatile("s_waitcnt vmcnt(0)" ::: "memory");
            const unsigned og = xb_add(&bar[XB_TOP], 1u);
            const unsigned tg = og / nx;
            if (og + 1u == (tg + 1u) * nx) xb_add(&bar[XB_TOPGEN], 1u);
            else XB_SPIN(xb_ld(&bar[XB_TOPGEN]) == tg, bar);
            __builtin_amdgcn_fence(__ATOMIC_ACQUIRE, "agent");
            asm volatile("s_waitcnt vmcnt(0)" ::: "memory");
        } else {
            XB_SPIN(xb_ld(&bar[XB_TOPGEN]) == gen, bar);
            __builtin_amdgcn_fence(__ATOMIC_ACQUIRE, "agent");
            asm volatile("s_waitcnt vmcnt(0)" ::: "memory");
        }
    }
    __syncthreads();
}
struct Frame {
    LAS unsigned char* lds;
    volatile LAS unsigned* MISC;
    gu32* ctl;
    int tid, lane, wave, G;
    GAS unsigned char* ws;
    const GAS float* in[16];
    GAS float* out;
};
__device__ __forceinline__ unsigned f2bf(float f) { unsigned u = __builtin_bit_cast(unsigned, f); return (u + 0x7fffu + ((u >> 16) & 1u)) >> 16; }
__device__ __forceinline__ unsigned pk2(float lo, float hi) { return f2bf(lo) | (f2bf(hi) << 16); }
__device__ __forceinline__ void p0_transpose_item(const float* W, int ldw, int K, int ncols, bf16* WT, const float* gain, int qrows, LAS float* scr, int item, int lane) {
    const int nblk = ncols / 32, kb = item / nblk, nb = item % nblk, k0 = 64 * kb, n0 = 32 * nb;
    const float sc = (n0 < qrows) ? 0.0625f : 1.0f;
    float wv[32];
#pragma unroll
    for (int i = 0; i < 32; ++i) wv[i] = W[(size_t)(k0 + 2 * i + (lane >> 5)) * ldw + n0 + (lane & 31)];
#pragma unroll
    for (int i = 0; i < 32; ++i) { const int kk = 2 * i + (lane >> 5); const float g = gain ? gain[k0 + kk] * sc : sc; scr[kk * 33 + (lane & 31)] = wv[i] * g; }
    LDS_WAIT(); asm volatile("" ::: "memory");
    const int c = lane & 7;
#pragma unroll
    for (int j = 0; j < 4; ++j) { const int n = (lane >> 3) + 8 * j; const LAS float* s = scr + (8 * c) * 33 + n;
        u32x4 o; o.x = pk2(s[0 * 33], s[1 * 33]); o.y = pk2(s[2 * 33], s[3 * 33]); o.z = pk2(s[4 * 33], s[5 * 33]); o.w = pk2(s[6 * 33], s[7 * 33]);
        *(u32x4*)(WT + (size_t)(n0 + n) * K + k0 + 8 * c) = o; }
    LDS_WAIT(); asm volatile("" ::: "memory");
}
__device__ __forceinline__ void p0_convert(const float* src, bf16* dst, size_t n8, const float* gain, size_t gtid, size_t gthreads) {
    for (size_t i = gtid; i < n8; i += gthreads) {
        const f32x4 a = *(const f32x4*)(src + i * 8), b = *(const f32x4*)(src + i * 8 + 4);
        f32x4 ga = {1.f, 1.f, 1.f, 1.f}, gb = ga;
        if (gain) { const int c = (int)((i * 8) & 2047); ga = *(const f32x4*)(gain + c); gb = *(const f32x4*)(gain + c + 4); }
        u32x4 o; o.x = cvtpk(a[0] * ga[0], a[1] * ga[1]); o.y = cvtpk(a[2] * ga[2], a[3] * ga[3]); o.z = cvtpk(b[0] * gb[0], b[1] * gb[1]); o.w = cvtpk(b[2] * gb[2], b[3] * gb[3]);
        *(u32x4*)(dst + i * 8) = o;
    }
}
__device__ __forceinline__ void p0_convert_sliced_fp4(const float* src, unsigned char* dst, const float* gain, float scale, size_t gtid, size_t gthreads) {
    const size_t n32 = (size_t)PEXP * DM / 32;
#pragma unroll 2
    for (size_t i = gtid; i < n32; i += gthreads) {
        const int c32 = (int)(i & 63); const size_t e = i >> 6;
        u32x4 o;
#pragma unroll
        for (int q = 0; q < 4; ++q) {
            f32x4 a0 = *(const f32x4*)(src + i * 32 + q * 8), a1 = *(const f32x4*)(src + i * 32 + q * 8 + 4);
            if (gain) { a0 = a0 * *(const f32x4*)(gain + c32 * 32 + q * 8); a1 = a1 * *(const f32x4*)(gain + c32 * 32 + q * 8 + 4); }
            a0 = a0 * scale; a1 = a1 * scale;
#pragma unroll
            for (int k = 0; k < 4; ++k) { a0[k] = __builtin_amdgcn_fmed3f(a0[k], -6.f, 6.f); a1[k] = __builtin_amdgcn_fmed3f(a1[k], -6.f, 6.f); }
            unsigned p4 = 0;
            p4 = __builtin_amdgcn_cvt_scalef32_pk_fp4_f32(p4, a0[0], a0[1], 1.0f, 0); p4 = __builtin_amdgcn_cvt_scalef32_pk_fp4_f32(p4, a0[2], a0[3], 1.0f, 1);
            p4 = __builtin_amdgcn_cvt_scalef32_pk_fp4_f32(p4, a1[0], a1[1], 1.0f, 2); p4 = __builtin_amdgcn_cvt_scalef32_pk_fp4_f32(p4, a1[2], a1[3], 1.0f, 3);
            o[q] = p4;
        }
        *(u32x4*)(dst + (((size_t)(c32 >> 3) * PEXP + e) * 8 + (c32 & 7)) * 16) = o;
    }
}
__device__ __forceinline__ void p0_convert_sliced_fp4v(const float* src, unsigned char* dst, float scale, size_t gtid, size_t gthreads) {
    const size_t n64 = (size_t)PEXP * DM / 64;
#pragma unroll 1
    for (size_t i = gtid; i < n64; i += gthreads) {
        const int w64 = (int)(i & 31); const size_t e = i >> 5;
        f32x4 a[16];
#pragma unroll
        for (int n = 0; n < 16; ++n) { a[n] = *(const f32x4*)(src + i * 64 + n * 4) * scale;
#pragma unroll
            for (int k = 0; k < 4; ++k) a[n][k] = __builtin_amdgcn_fmed3f(a[n][k], -6.f, 6.f); }
        u32x4 o0, o1;
#pragma unroll
        for (int d = 0; d < 4; ++d) {
            const int k = d >> 1, nb = 8 * (d & 1);
            unsigned p0 = 0, p1 = 0;
            p0 = __builtin_amdgcn_cvt_scalef32_pk_fp4_f32(p0, a[nb + 0][k], a[nb + 1][k], 1.0f, 0); p0 = __builtin_amdgcn_cvt_scalef32_pk_fp4_f32(p0, a[nb + 2][k], a[nb + 3][k], 1.0f, 1);
            p0 = __builtin_amdgcn_cvt_scalef32_pk_fp4_f32(p0, a[nb + 4][k], a[nb + 5][k], 1.0f, 2); p0 = __builtin_amdgcn_cvt_scalef32_pk_fp4_f32(p0, a[nb + 6][k], a[nb + 7][k], 1.0f, 3);
            p1 = __builtin_amdgcn_cvt_scalef32_pk_fp4_f32(p1, a[nb + 0][k + 2], a[nb + 1][k + 2], 1.0f, 0); p1 = __builtin_amdgcn_cvt_scalef32_pk_fp4_f32(p1, a[nb + 2][k + 2], a[nb + 3][k + 2], 1.0f, 1);
            p1 = __builtin_amdgcn_cvt_scalef32_pk_fp4_f32(p1, a[nb + 4][k + 2], a[nb + 5][k + 2], 1.0f, 2); p1 = __builtin_amdgcn_cvt_scalef32_pk_fp4_f32(p1, a[nb + 6][k + 2], a[nb + 7][k + 2], 1.0f, 3);
            o0[d] = p0; o1[d] = p1;
        }
        unsigned char* piece = dst + ((size_t)(w64 >> 2) * PEXP + e) * 128;
        *(u32x4*)(piece + (w64 & 3) * 16) = o0; *(u32x4*)(piece + ((w64 & 3) + 4) * 16) = o1;
    }
}
__device__ __forceinline__ void p0_prologue(Frame& F) {
    const float* x = (const float*)F.in[0]; const float* ln_mix = (const float*)F.in[1]; const float* ln_ffn = (const float*)F.in[2]; const float* w_in = (const float*)F.in[3]; const float* gate_bias = (const float*)F.in[4];
    const float* w_out = (const float*)F.in[6]; const float* a_in = (const float*)F.in[7]; const float* a_out = (const float*)F.in[10]; const float* wq = (const float*)F.in[11];
    const float* k1 = (const float*)F.in[12]; const float* k2 = (const float*)F.in[13]; const float* pu = (const float*)F.in[14]; const float* pv = (const float*)F.in[15];
    GAS unsigned char* ws = F.ws;
    const int gw = blockIdx.x * NWAVES + F.wave, NGW = F.G * NWAVES;
    const size_t gtid = (size_t)blockIdx.x * NTHREADS + F.tid, gthreads = (size_t)F.G * NTHREADS;
#ifndef REP_P0
#define REP_P0 0
#endif
    for (int rp_ = 0; rp_ < 1 + (REP_P0 & 1); ++rp_) {
        LAS float* scr = (LAS float*)(F.lds + F.wave * 16384);
        constexpr int I_IN = (DM / 64) * (MPROJ / 32), I_SQ = (DM / 64) * (DM / 32), I_AIN = (DM / 64) * (APROJ / 32);
        constexpr int NITEMS = I_IN + I_SQ + I_AIN + I_SQ + 2 * I_SQ;
        for (int it = gw; it < NITEMS; it += NGW) {
            int r = it;
            if (r < I_IN) { p0_transpose_item(w_in, MLSTM_IN, DM, MPROJ, (bf16*)(ws + WS_WIN), ln_mix, 1024, scr, r, F.lane); continue; } r -= I_IN;
            if (r < I_SQ) { p0_transpose_item(w_out, DM, DM, DM, (bf16*)(ws + WS_WOUT), nullptr, 0, scr, r, F.lane); continue; } r -= I_SQ;
            if (r < I_AIN) { p0_transpose_item(a_in, APROJ, DM, APROJ, (bf16*)(ws + WS_AIN), ln_mix + DM, 0, scr, r, F.lane); continue; } r -= I_AIN;
            if (r < I_SQ) { p0_transpose_item(a_out, DM, DM, DM, (bf16*)(ws + WS_AOUT), nullptr, 0, scr, r, F.lane); continue; } r -= I_SQ;
            if (r < I_SQ) { p0_transpose_item(wq, DM, DM, DM, (bf16*)(ws + WS_WQ), ln_ffn, 0, scr, r, F.lane); continue; } r -= I_SQ;
            p0_transpose_item(wq + (size_t)DM * DM, DM, DM, DM, (bf16*)(ws + WS_WQ) + (size_t)DM * DM, ln_ffn + DM, 0, scr, r, F.lane);
        }
    }
    for (int rp_ = 0; rp_ < 1 + ((REP_P0 >> 1) & 1); ++rp_) {
        for (int l = 0; l < 2; ++l) {
            p0_convert_sliced_fp4(pu + (size_t)l * PEXP * DM, (unsigned char*)(ws + WS_UB) + (size_t)l * PEXP * (DM / 2), ln_ffn + l * DM, PEER_U4_SCALE, gtid, gthreads);
            p0_convert_sliced_fp4v(pv + (size_t)l * PEXP * DM, (unsigned char*)(ws + WS_VB) + (size_t)l * PEXP * (DM / 2), 5.656854249f, gtid, gthreads);
            p0_convert(k1 + (size_t)l * PKEYS * PHALF, (bf16*)(ws + WS_PK) + (size_t)(l * 2 + 0) * PKEYS * PHALF, (size_t)PKEYS * PHALF / 8, nullptr, gtid, gthreads);
            p0_convert(k2 + (size_t)l * PKEYS * PHALF, (bf16*)(ws + WS_PK) + (size_t)(l * 2 + 1) * PKEYS * PHALF, (size_t)PKEYS * PHALF / 8, nullptr, gtid, gthreads);
        }
        float* cosT = (float*)(ws + WS_ROPE); float* sinT = cosT + SEQ * 64;
        for (size_t i = gtid; i < (size_t)SEQ * 64; i += gthreads) {
            const int t = (int)(i >> 6), j = (int)(i & 63);
            const float freq = powf(10000.0f, -(float)(j & 31) / 32.0f);
            const float pos = (j < 32) ? (float)(t >> 6) : (float)(t & 63);
            const float ang = pos * freq;
            cosT[i] = cosf(ang); sinT[i] = sinf(ang);
        }
    }
    __syncthreads();
    for (int rp_ = 0; rp_ < 1 + ((REP_P0 >> 2) & 1); ++rp_) {
        __syncthreads();
        LAS float* Wg = (LAS float*)F.lds;
        for (int i = F.tid; i < 16 * DM; i += NTHREADS) { const int k = i >> 4, g = i & 15; Wg[g * DM + k] = w_in[(size_t)k * MLSTM_IN + MPROJ + g] * ln_mix[k]; }
        __syncthreads();
        float* rstd0 = (float*)(ws + WS_RSTD); float* gates = (float*)(ws + WS_GATE); bf16* xb = (bf16*)(ws + WS_XB0);
        f32x4 vn[8];
        if (gw < TOK) { const f32x4* xr0 = (const f32x4*)(x + (size_t)gw * DM) + F.lane;
#pragma unroll
            for (int j = 0; j < 8; ++j) vn[j] = xr0[64 * j]; }
        for (int m = gw; m < TOK; m += NGW) {
            f32x4 v[8]; float ss = 0.f;
#pragma unroll
            for (int j = 0; j < 8; ++j) { v[j] = vn[j]; ss += (v[j][0] * v[j][0] + v[j][1] * v[j][1]) + (v[j][2] * v[j][2] + v[j][3] * v[j][3]); }
            { const int mn = (m + NGW < TOK) ? m + NGW : m; const f32x4* xrn = (const f32x4*)(x + (size_t)mn * DM) + F.lane;
#pragma unroll
              for (int j = 0; j < 8; ++j) vn[j] = xrn[64 * j]; }
            const float rstd = 1.0f / sqrtf(wave_sum(ss) * (1.0f / DM) + NORM_EPS);
            u32x2* o8 = (u32x2*)(xb + (size_t)m * DM) + F.lane;
#pragma unroll
            for (int j = 0; j < 8; ++j) { u32x2 w; w.x = cvtpk(v[j][0], v[j][1]); w.y = cvtpk(v[j][2], v[j][3]); o8[64 * j] = w; }
            float mine = 0.f;
#pragma unroll
            for (int g = 0; g < 16; ++g) {
                float s = 0.f;
#pragma unroll
                for (int j = 0; j < 8; ++j) { const f32x4 w = *(const LAS f32x4*)(Wg + g * DM + 256 * j + 4 * F.lane); s += (v[j][0] * w[0] + v[j][1] * w[1]) + (v[j][2] * w[2] + v[j][3] * w[3]); }
                s = wave_sum(s);
                if (F.lane == g) mine = s;
            }
            if (F.lane < 16) gates[(size_t)m * 16 + F.lane] = mine * rstd + gate_bias[F.lane];
            if (F.lane == 0) rstd0[m] = rstd;
        }
    }
    __syncthreads();
}
__device__ __forceinline__ int crow(int r, int hi) { return (r & 3) + 8 * (r >> 2) + 4 * hi; }
template <int ND0, int ROWB>
__device__ __forceinline__ void qkt(f32x16& p0, f32x16& p1, const char* Ks, const bf16x8* qr, int r32, int hi) {
    p0 = f32x16{}; p1 = f32x16{};
    int sw = (r32 & 7) << 4;
    asm volatile("" : "+v"(sw));
#pragma unroll
    for (int d0 = 0; d0 < ND0; ++d0) { const int cb = (d0 * 16 + hi * 8) * 2;
        const bf16x8 b0 = *reinterpret_cast<const bf16x8*>(Ks + r32 * ROWB + (cb ^ sw));
        const bf16x8 b1 = *reinterpret_cast<const bf16x8*>(Ks + (32 + r32) * ROWB + (cb ^ sw));
        p0 = __builtin_amdgcn_mfma_f32_32x32x16_bf16(b0, qr[d0], p0, 0, 0, 0);
        p1 = __builtin_amdgcn_mfma_f32_32x32x16_bf16(b1, qr[d0], p1, 0, 0, 0); }
}
__device__ __forceinline__ int v_st(int k, int c) { const int kk = (k & ~0xC) | ((k & 4) << 1) | ((k & 8) >> 1); return ((kk >> 3) * 4 + (c >> 5)) * 512 + ((kk & 7) * 32 + (c & 31)) * 2; }
__device__ __forceinline__ int v_rd_base(int lane) { return ((lane & 3) << 3) | (((lane >> 2) & 3) << 6) | (((lane >> 4) & 1) << 5) | (((lane >> 5) & 1) << 8); }
constexpr int v_rd_off(int d0, int ks, int half) { return d0 * 512 + ks * 4096 + half * 2048; }
template <int OFF> __device__ __forceinline__ s16x4 tr_read(int vb) {
    s16x4 r; asm volatile("ds_read_b64_tr_b16 %0, %1 offset:%2" : "=&v"(r) : "v"(vb), "i"(OFF) : "memory"); return r;
}
template <int D0> __device__ __forceinline__ void pv_one(f32x16& od, int vb, bf16x8 pa0, bf16x8 pa1, bf16x8 pa2, bf16x8 pa3) {
    const s16x4 l0 = tr_read<v_rd_off(D0, 0, 0)>(vb), h0 = tr_read<v_rd_off(D0, 0, 1)>(vb), l1 = tr_read<v_rd_off(D0, 1, 0)>(vb), h1 = tr_read<v_rd_off(D0, 1, 1)>(vb);
    const s16x4 l2 = tr_read<v_rd_off(D0, 2, 0)>(vb), h2 = tr_read<v_rd_off(D0, 2, 1)>(vb), l3 = tr_read<v_rd_off(D0, 3, 0)>(vb), h3 = tr_read<v_rd_off(D0, 3, 1)>(vb);
    asm volatile("s_waitcnt lgkmcnt(0)" ::: "memory"); SBAR();
#define PKV(L, H) (bf16x8){L[0], L[1], L[2], L[3], H[0], H[1], H[2], H[3]}
    od = __builtin_amdgcn_mfma_f32_32x32x16_bf16(pa0, PKV(l0, h0), od, 0, 0, 0);
    od = __builtin_amdgcn_mfma_f32_32x32x16_bf16(pa1, PKV(l1, h1), od, 0, 0, 0);
    od = __builtin_amdgcn_mfma_f32_32x32x16_bf16(pa2, PKV(l2, h2), od, 0, 0, 0);
    od = __builtin_amdgcn_mfma_f32_32x32x16_bf16(pa3, PKV(l3, h3), od, 0, 0, 0);
#undef PKV
}
__device__ __forceinline__ void pv_d0(f32x16* o, int vb, bf16x8 pa0, bf16x8 pa1, bf16x8 pa2, bf16x8 pa3) {
    pv_one<0>(o[0], vb, pa0, pa1, pa2, pa3); pv_one<1>(o[1], vb, pa0, pa1, pa2, pa3); pv_one<2>(o[2], vb, pa0, pa1, pa2, pa3); pv_one<3>(o[3], vb, pa0, pa1, pa2, pa3);
}
#define PK4(P, BASE, OUT) do { unsigned a0_ = cvtpk(P[BASE + 0], P[BASE + 1]), a1_ = cvtpk(P[BASE + 2], P[BASE + 3]);   \
    unsigned b0_ = cvtpk(P[BASE + 4], P[BASE + 5]), b1_ = cvtpk(P[BASE + 6], P[BASE + 7]);                              \
    auto r0_ = __builtin_amdgcn_permlane32_swap(a0_, b0_, false, false); auto r1_ = __builtin_amdgcn_permlane32_swap(a1_, b1_, false, false); \
    u32x4 w_ = {r0_[0], r1_[0], r0_[1], r1_[1]}; OUT = *reinterpret_cast<bf16x8*>(&w_); } while (0)

namespace ml {
constexpr int LD = MPROJ;
constexpr int SHM_V = 64 * 128 * 2, SHM_K = 64 * 256 * 2;
constexpr int OFF_V = 0, OFF_K = 2 * SHM_V, OFF_WS = OFF_K + 2 * SHM_K, OFF_G = OFF_WS + NWAVES * 256, LDS_END = OFF_G + 2 * SEQ * 4;
static_assert(LDS_END <= RING_BYTES, "mlstm LDS");
constexpr float LOG2E = 1.4426950408889634f;

__device__ __forceinline__ void scan(Frame& F, int bh, int dir) {
    const int b = bh >> 2, h = bh & 3;
    const float* gates = (const float*)(F.ws + WS_GATE);
    float* SC = (float*)(F.ws + WS_SC) + (size_t)bh * 6 * SEQ;
    LAS float* red = (LAS float*)F.lds;
    {
        float ig[4], s[4]; int tt[4];
#pragma unroll
        for (int j = 0; j < 4; ++j) { const int p = F.tid * 4 + j, t = dir ? (SEQ - 1 - p) : p; tt[j] = t;
            const float* gr = gates + (size_t)(b * SEQ + t) * 16; ig[j] = gr[dir * 8 + h]; const float fg = gr[dir * 8 + 4 + h];
            s[j] = fminf(fg, 0.f) - log1pf(expf(-fabsf(fg))); }
        s[1] += s[0]; s[2] += s[1]; s[3] += s[2];
        const float tot = s[3]; float inc = tot;
#pragma unroll
        for (int o = 1; o < 64; o <<= 1) { const float n = __shfl_up(inc, o); if (F.lane >= o) inc += n; }
        if (F.lane == 63) red[F.wave] = inc;
        __syncthreads();
        float woff = 0.f;
        for (int w = 0; w < F.wave; ++w) woff += red[w];
        const float excl = woff + inc - tot;
        float Bv[4], g[4], pm[4];
#pragma unroll
        for (int j = 0; j < 4; ++j) { Bv[j] = excl + s[j]; g[j] = ig[j] - Bv[j]; }
        pm[0] = g[0]; pm[1] = fmaxf(pm[0], g[1]); pm[2] = fmaxf(pm[1], g[2]); pm[3] = fmaxf(pm[2], g[3]);
        float minc = pm[3];
#pragma unroll
        for (int o = 1; o < 64; o <<= 1) { const float n = __shfl_up(minc, o); if (F.lane >= o) minc = fmaxf(minc, n); }
        if (F.lane == 63) red[16 + F.wave] = minc;
        __syncthreads();
        float wmax = -3.0e38f;
        for (int w = 0; w < F.wave; ++w) wmax = fmaxf(wmax, red[16 + w]);
        const float prev = __shfl_up(minc, 1);
        const float exm = (F.lane > 0) ? fmaxf(wmax, prev) : wmax;
#pragma unroll
        for (int j = 0; j < 4; ++j) { const float c = fmaxf(0.f, fmaxf(exm, pm[j])); const float m = Bv[j] + c;
            SC[(dir * 3 + 0) * SEQ + tt[j]] = g[j] * LOG2E; SC[(dir * 3 + 1) * SEQ + tt[j]] = c * LOG2E; SC[(dir * 3 + 2) * SEQ + tt[j]] = expf(-m); }
        __syncthreads();
    }
}

}
namespace ml2 {
constexpr int LD = MPROJ;
constexpr int KT = 32;
constexpr int SHM_K = KT * 512, SHM_V = KT * 1024;
constexpr int NBUF = 3;
constexpr int OFF_K = 0, OFF_V = NBUF * SHM_K, OFF_WS = OFF_V + NBUF * SHM_V, OFF_G = OFF_WS + NWAVES * 256, LDS_END = OFF_G + SEQ * 4;
static_assert(LDS_END <= RING_BYTES, "mlstm16 LDS");

template <int DIR, int VAR = 0>
__device__ __forceinline__ void pass(const bf16* Qb, const bf16* Kh, const bf16* Vh, bf16* Hb, const float* C2g, const float* ECg, int r0u, char* lds) {
    const int tid = opaque_tid(), wid = tid >> 6, lane = tid & 63, n16 = lane & 15, g = lane >> 4, q4 = n16 >> 2, p4 = lane & 3;
    const int wu = __builtin_amdgcn_readfirstlane(wid);
    char* K_lds = lds + OFF_K; char* V_lds = lds + OFF_V;
    const float* Gf = (const float*)(lds + OFF_G);
    float* li_l = (float*)(lds + OFF_WS) + wid * 64; float* ec_l = li_l + 32;
    const int rlo = r0u + wid * 16, rhi = rlo + 15, trow = rlo + n16;
    bf16x8 qr[8];
    { const bf16* Qw = Qb + (size_t)(wid * 16 + n16) * LD + 8 * g;
#pragma unroll
      for (int s = 0; s < 8; ++s) qr[s] = *reinterpret_cast<const bf16x8*>(Qw + 32 * s); }
    const float c2 = C2g[trow], ec = ECg[trow];
    f32x4 o[32];
#pragma unroll
    for (int i = 0; i < 32; ++i) o[i] = (f32x4){0.f, 0.f, 0.f, 0.f};
    float den = 0.f;
    const int j0 = DIR == 0 ? 0 : (r0u >> 5), n = DIR == 0 ? (r0u >> 5) + 4 : 64 - (r0u >> 5);
    unsigned koff[2], voff[4];
#pragma unroll
    for (int i_ = 0; i_ < 2; ++i_) { const int row_ = 2 * (wid * 2 + i_) + (lane >> 5), kc_ = (lane & 31) ^ (row_ & 15); koff[i_] = (unsigned)(row_ * LD + kc_ * 8); }
#pragma unroll
    for (int i_ = 0; i_ < 4; ++i_) { const int pc = wid * 4 + i_, sl = pc >> 3, oo = (pc >> 1) & 3, cb = 4 * (pc & 1) + (lane >> 4), kq = (lane >> 1) & 7;
        voff[i_] = (unsigned)((8 * oo + kq) * LD + sl * 128 + 16 * cb + 8 * (lane & 1)); }
#define M2_STAGE(b, k0) do { _Pragma("unroll") for (int i_ = 0; i_ < 2; ++i_) \
        __builtin_amdgcn_global_load_lds((const unsigned*)(Kh + (size_t)(k0) * LD + koff[i_]), (LAS unsigned*)(uintptr_t)(unsigned)((unsigned)(uintptr_t)K_lds + (b) * SHM_K + (wu * 2 + i_) * 1024), 16, 0, 0); \
        _Pragma("unroll") for (int i_ = 0; i_ < 4; ++i_) \
        __builtin_amdgcn_global_load_lds((const unsigned*)(Vh + (size_t)(k0) * LD + voff[i_]), (LAS unsigned*)(uintptr_t)(unsigned)((unsigned)(uintptr_t)V_lds + (b) * SHM_V + (wu * 4 + i_) * 1024), 16, 0, 0); } while (0)
    int ksw = n16 << 4; asm volatile("" : "+v"(ksw));
    const int trb = (int)(uintptr_t)V_lds + (g >> 1) * 2048 + (4 * (g & 1) + q4) * 32 + p4 * 8;
#define M2_RD(cb, sl, L, H) L = tr_read<(sl) * 8192 + (cb) * 256>(trv); H = tr_read<(sl) * 8192 + (cb) * 256 + 4096>(trv)
#define M2_MM(cb, sl, L, H) o[(sl) * 8 + (cb)] = __builtin_amdgcn_mfma_f32_16x16x32_bf16(pa, (bf16x8){L[0], L[1], L[2], L[3], H[0], H[1], H[2], H[3]}, o[(sl) * 8 + (cb)], 0, 0, 0)
#define M2_RD4(q, L, H) do { M2_RD(4 * ((q) & 1) + 0, (q) >> 1, L##0, H##0); M2_RD(4 * ((q) & 1) + 1, (q) >> 1, L##1, H##1); M2_RD(4 * ((q) & 1) + 2, (q) >> 1, L##2, H##2); M2_RD(4 * ((q) & 1) + 3, (q) >> 1, L##3, H##3); } while (0)
#define M2_MM4(q, L, H) do { M2_MM(4 * ((q) & 1) + 0, (q) >> 1, L##0, H##0); M2_MM(4 * ((q) & 1) + 1, (q) >> 1, L##1, H##1); M2_MM(4 * ((q) & 1) + 2, (q) >> 1, L##2, H##2); M2_MM(4 * ((q) & 1) + 3, (q) >> 1, L##3, H##3); } while (0)
#define M2_WAIT8() do { asm volatile("s_waitcnt lgkmcnt(8)" ::: "memory"); SBAR(); } while (0)
#define M2_WAIT0() do { asm volatile("s_waitcnt lgkmcnt(0)" ::: "memory"); SBAR(); } while (0)
#define M2_PV() do { s16x4 xa0, xa1, xa2, xa3, ya0, ya1, ya2, ya3, xb0, xb1, xb2, xb3, yb0, yb1, yb2, yb3; \
        M2_RD4(0, xa, ya); \
        M2_RD4(1, xb, yb); M2_WAIT8(); M2_MM4(0, xa, ya); \
        M2_RD4(2, xa, ya); M2_WAIT8(); M2_MM4(1, xb, yb); \
        M2_RD4(3, xb, yb); M2_WAIT8(); M2_MM4(2, xa, ya); \
        M2_RD4(4, xa, ya); M2_WAIT8(); M2_MM4(3, xb, yb); \
        M2_RD4(5, xb, yb); M2_WAIT8(); M2_MM4(4, xa, ya); \
        M2_RD4(6, xa, ya); M2_WAIT8(); M2_MM4(5, xb, yb); \
        M2_RD4(7, xb, yb); M2_WAIT8(); M2_MM4(6, xa, ya); \
        M2_WAIT0(); M2_MM4(7, xb, yb); } while (0)
    { float* Gl = (float*)(lds + OFF_G); const float* Gs = C2g - SEQ;
      for (int i = tid; i < SEQ; i += NTHREADS) Gl[i] = Gs[i]; }
    M2_STAGE(0, j0 * KT); M2_STAGE(1, (j0 + 1) * KT);
    asm volatile("s_waitcnt vmcnt(6)" ::: "memory"); __syncthreads();
    for (int i = 0; i < n; ++i) {
        const int cur = i % NBUF, k0 = (j0 + i) * KT;
        if (VAR != 1 && i + 2 < n) M2_STAGE((i + 2) % NBUF, k0 + 2 * KT);
        const bool full = DIR == 0 ? (k0 + KT - 1 <= rlo) : (k0 >= rhi);
        const bool none = DIR == 0 ? (k0 > rhi) : (k0 + KT - 1 < rlo);
        if (!none) {
            f32x4 p0 = {0.f, 0.f, 0.f, 0.f}, p1 = {0.f, 0.f, 0.f, 0.f};
            if (VAR != 3) { const char* Kc = K_lds + cur * SHM_K + n16 * 512;
#pragma unroll
              for (int s = 0; s < 8; ++s) { const int off = (64 * s + 16 * g) ^ ksw;
                  const bf16x8 a0 = *reinterpret_cast<const bf16x8*>(Kc + off), a1 = *reinterpret_cast<const bf16x8*>(Kc + 8192 + off);
                  p0 = __builtin_amdgcn_mfma_f32_16x16x32_bf16(a0, qr[s], p0, 0, 0, 0);
                  p1 = __builtin_amdgcn_mfma_f32_16x16x32_bf16(a1, qr[s], p1, 0, 0, 0); } }
            const f32x4 ga = *reinterpret_cast<const f32x4*>(Gf + k0 + 4 * g), gb = *reinterpret_cast<const f32x4*>(Gf + k0 + 16 + 4 * g);
            float ps = 0.f;
#pragma unroll
            for (int r = 0; r < 4; ++r) {
                float w0 = __builtin_amdgcn_exp2f(ga[r] - c2), w1 = __builtin_amdgcn_exp2f(gb[r] - c2);
                if (!full) { const int key = k0 + 4 * g + r;
                    const bool ok0 = DIR == 0 ? (key <= trow) : (key >= trow), ok1 = DIR == 0 ? (key + 16 <= trow) : (key + 16 >= trow);
                    w0 = ok0 ? w0 : 0.f; w1 = ok1 ? w1 : 0.f; }
                p0[r] *= w0; p1[r] *= w1; ps += p0[r] + p1[r]; }
            ps += __shfl_xor(ps, 16); ps += __shfl_xor(ps, 32);
            den += ps;
            u32x4 paw = {cvtpk(p0[0], p0[1]), cvtpk(p0[2], p0[3]), cvtpk(p1[0], p1[1]), cvtpk(p1[2], p1[3])};
            const bf16x8 pa = *reinterpret_cast<bf16x8*>(&paw);
            const int trv = trb + cur * SHM_V;
            SBAR();
            if (VAR != 2) M2_PV();
        }
        if (VAR != 1 && i + 2 < n) asm volatile("s_waitcnt vmcnt(6)" ::: "memory"); else asm volatile("s_waitcnt vmcnt(0)" ::: "memory");
        if (VAR != 4) __syncthreads();
    }
#undef M2_PV
#undef M2_WAIT0
#undef M2_WAIT8
#undef M2_MM4
#undef M2_RD4
#undef M2_MM
#undef M2_RD
#undef M2_STAGE
    if (g == 0) { li_l[n16] = den; ec_l[n16] = ec; }
    asm volatile("s_waitcnt lgkmcnt(0)" ::: "memory");
    float rs[4];
#pragma unroll
    for (int r = 0; r < 4; ++r) rs[r] = __builtin_amdgcn_rcpf(fmaxf(fabsf(li_l[4 * g + r]), ec_l[4 * g + r]));
    GAS bf16* Hw = (GAS bf16*)(Hb + (size_t)(wid * 16 + 4 * g) * DM + n16);
    asm volatile("" : "+v"(Hw));
#pragma unroll
    for (int sl = 0; sl < 4; ++sl)
#pragma unroll
        for (int cb = 0; cb < 8; ++cb)
#pragma unroll
            for (int r = 0; r < 4; ++r) { if (VAR != 5) Hw[(size_t)r * DM + sl * 128 + cb * 16] = (bf16)f2bf(o[sl * 8 + cb][r] * rs[r]); else asm volatile("" :: "v"(o[sl * 8 + cb][r] * rs[r])); }
    asm volatile("s_waitcnt lgkmcnt(0)" ::: "memory");
}

template <int VAR = 0>
__device__ __forceinline__ void phase(Frame& F) {
    const bf16* PROJ = (const bf16*)(F.ws + WS_PROJ); bf16* HS = (bf16*)(F.ws + (VAR ? WS_PSCR : WS_HS)); bf16* HS2 = (bf16*)(F.ws + (VAR ? WS_PSCR : WS_XB1)); bf16* HB = (bf16*)(F.ws + (VAR ? WS_PSCR : WS_HB));
    const float* hn = (const float*)F.in[5];
    const int G = F.G; const int x = blockIdx.x & 7, jx = blockIdx.x >> 3, per = G >> 3;
    const bool loc = (G % 8 == 0);
    for (int v = loc ? jx : (int)blockIdx.x; v < (loc ? 64 : 512); v += (loc ? per : G)) {
        const int bh = loc ? (4 * x + (v >> 4)) : (v >> 4), blk = v & 15;
        const int b = bh >> 2, h = bh & 3, r0u = blk * 128;
        const float* SC = (const float*)(F.ws + WS_SC) + (size_t)bh * 6 * SEQ;
        const bf16* rowb = PROJ + (size_t)(b * SEQ) * LD;
        const bf16* Qb = rowb + (size_t)r0u * LD + h * MDK;
        const bf16* Kh = rowb + 1024 + h * MDK;
        const bf16* Vh = rowb + 2048 + h * MDV;
        const size_t ho = (size_t)(b * SEQ + r0u) * DM + h * MDV;
        pass<0, (VAR > 0 ? VAR - 1 : 0)>(Qb, Kh, Vh, HS + ho, SC + 1 * SEQ, SC + 2 * SEQ, r0u, (char*)F.lds);
        pass<1, (VAR > 0 ? VAR - 1 : 0)>(Qb, Kh, Vh, HS2 + ho, SC + 4 * SEQ, SC + 5 * SEQ, r0u, (char*)F.lds);
        asm volatile("s_waitcnt vmcnt(0)" ::: "memory");
        { const int wid = F.wave, lane = F.lane;
          const f32x4 wa = *(const f32x4*)(hn + h * MDV + lane * 8), wb = *(const f32x4*)(hn + h * MDV + lane * 8 + 4);
          const float w[8] = {wa[0], wa[1], wa[2], wa[3], wb[0], wb[1], wb[2], wb[3]};
          for (int rr = 0; rr < 16; rr += 4) {
              u32x4 hv[4], hw[4], ov[4];
#pragma unroll
              for (int q = 0; q < 4; ++q) { const size_t ro = ho + (size_t)(wid * 16 + rr + q) * DM + lane * 8;
                  hv[q] = *(const u32x4*)(HS + ro); hw[q] = *(const u32x4*)(HS2 + ro);
                  ov[q] = *(const u32x4*)(PROJ + (size_t)(b * SEQ + r0u + wid * 16 + rr + q) * LD + 4096 + h * MDV + lane * 8); }
#pragma unroll
              for (int q = 0; q < 4; ++q) {
                  float v[8] = {bf_lo(hv[q].x) + bf_lo(hw[q].x), bf_hi(hv[q].x) + bf_hi(hw[q].x), bf_lo(hv[q].y) + bf_lo(hw[q].y), bf_hi(hv[q].y) + bf_hi(hw[q].y),
                                bf_lo(hv[q].z) + bf_lo(hw[q].z), bf_hi(hv[q].z) + bf_hi(hw[q].z), bf_lo(hv[q].w) + bf_lo(hw[q].w), bf_hi(hv[q].w) + bf_hi(hw[q].w)};
                  const float og[8] = {bf_lo(ov[q].x), bf_hi(ov[q].x), bf_lo(ov[q].y), bf_hi(ov[q].y), bf_lo(ov[q].z), bf_hi(ov[q].z), bf_lo(ov[q].w), bf_hi(ov[q].w)};
                  float ss = 0.f;
#pragma unroll
                  for (int k = 0; k < 8; ++k) ss += v[k] * v[k];
                  const float rstd = 1.0f / sqrtf(wave_sum(ss) * (1.0f / MDV) + NORM_EPS);
#pragma unroll
                  for (int k = 0; k < 8; ++k) v[k] = v[k] * rstd * w[k] * og[k];
                  u32x4 oo; oo.x = cvtpk(v[0], v[1]); oo.y = cvtpk(v[2], v[3]); oo.z = cvtpk(v[4], v[5]); oo.w = cvtpk(v[6], v[7]);
                  *(u32x4*)(HB + ho + (size_t)(wid * 16 + rr + q) * DM + lane * 8) = oo; }
          }
        }
    }
    __syncthreads();
}
}
namespace at {
#ifndef ATT_OUT_SCALE
#define ATT_OUT_SCALE 1.0f
#endif
constexpr int D = 128, QBLK = 32, KVBLK = 64;
constexpr float SCALE = 0.088388347648318440f;
constexpr float THR = 8.f;
constexpr int SDEPTH = 1;
constexpr int LDQ = APROJ, LDK = APROJ, LDO = DM;
constexpr int SHM_V = KVBLK * D * 2, SHM_K = KVBLK * D * 2, SHM_ATTN = 2 * SHM_V + 2 * SHM_K + NWAVES * 64 * 4;
static_assert(SHM_ATTN <= RING_BYTES, "attn LDS");
#define KSWZ(row, colB) ((row) * 256 + ((colB) ^ (((row) & 7) << 4)))

__device__ __forceinline__ void partialSM(f32x16& p0, f32x16& p1, float& m_reg, float& mn, float& alpha) {
    constexpr float C = SCALE * 1.4426950408889634f;
    float pmax = p0[0];
#pragma unroll
    for (int r = 1; r < 16; ++r) pmax = fmaxf(pmax, p0[r]);
#pragma unroll
    for (int r = 0; r < 16; ++r) pmax = fmaxf(pmax, p1[r]);
    { auto rr = __builtin_amdgcn_permlane32_swap(__float_as_uint(pmax), __float_as_uint(pmax), false, false);
      pmax = fmaxf(__uint_as_float(rr[0]), __uint_as_float(rr[1])); }
    if (__builtin_expect(__all(pmax - m_reg <= THR / SCALE), 1)) { mn = m_reg; alpha = 1.f; }
    else { mn = fmaxf(m_reg, pmax); alpha = __builtin_amdgcn_exp2f((m_reg - mn) * C); m_reg = mn; }
    const float mnC = -mn * C;
#pragma unroll
    for (int r = 0; r < 16; ++r) p0[r] = fmaf(p0[r], C, mnC);
#pragma unroll
    for (int r = 0; r < 16; ++r) p1[r] = fmaf(p1[r], C, mnC);
#pragma unroll
    for (int r = 0; r < 16; ++r) p0[r] = __builtin_amdgcn_exp2f(p0[r]);
}
__device__ __forceinline__ void finishSM(f32x16& p0, f32x16& p1, float alpha, float& l_reg, bf16x8& pa0, bf16x8& pa1, bf16x8& pa2, bf16x8& pa3) {
#pragma unroll
    for (int r = 0; r < 16; ++r) p1[r] = __builtin_amdgcn_exp2f(p1[r]);
    float ps = 0;
#pragma unroll
    for (int r = 0; r < 16; ++r) ps += p0[r];
#pragma unroll
    for (int r = 0; r < 16; ++r) ps += p1[r];
    { auto rr = __builtin_amdgcn_permlane32_swap(__float_as_uint(ps), __float_as_uint(ps), false, false);
      ps = __uint_as_float(rr[0]) + __uint_as_float(rr[1]); }
    l_reg = l_reg * alpha + ps;
    PK4(p0, 0, pa0); PK4(p0, 8, pa1); PK4(p1, 0, pa2); PK4(p1, 8, pa3);
}
__device__ __forceinline__ void attn_dense_body(const bf16* __restrict__ Qb, const bf16* __restrict__ Kh, const bf16* __restrict__ Vh, bf16* __restrict__ Ob, int seq, char* lds) {
    const int tid = opaque_tid(), wid = tid >> 6, lane = tid & 63, r32 = lane & 31, hi = lane >> 5;
    char* V_lds = lds; char* K_lds = lds + 2 * SHM_V;
    float* wsf = (float*)(lds + 2 * SHM_V + 2 * SHM_K) + wid * 64; float* li_l = wsf; float* al_l = wsf + 32;
    float m_reg = -1e30f, l_reg = 0; f32x16 o[4] = {}; bf16x8 qr[8];
    const bf16* Qw = Qb + (long)(wid * QBLK + r32) * LDQ + hi * 8;
#pragma unroll
    for (int d0 = 0; d0 < 8; ++d0) qr[d0] = *reinterpret_cast<const bf16x8*>(Qw + d0 * 16);
    const int sr = tid >> 4, sc = (tid & 15) * 8, vst0 = v_st(sr, sc), vst1 = v_st(32 + sr, sc);
    const int vb0 = (int)(uintptr_t)V_lds + v_rd_base(lane);
    struct { bf16x8 vs0, vs1, ks0, ks1; } sr_[SDEPTH];
#define SLOAD(i, k0) do { sr_[i].vs0 = *reinterpret_cast<const bf16x8*>(&Vh[(long)((k0) + sr) * LDK + sc]); sr_[i].vs1 = *reinterpret_cast<const bf16x8*>(&Vh[(long)((k0) + 32 + sr) * LDK + sc]); \
    sr_[i].ks0 = *reinterpret_cast<const bf16x8*>(&Kh[(long)((k0) + sr) * LDK + sc]); sr_[i].ks1 = *reinterpret_cast<const bf16x8*>(&Kh[(long)((k0) + 32 + sr) * LDK + sc]); } while (0)
#define SWRITE(b, i) do { *(bf16x8*)(V_lds + (b) * SHM_V + vst0) = sr_[i].vs0;          \
    *(bf16x8*)(V_lds + (b) * SHM_V + vst1) = sr_[i].vs1; int kc_ = sc * 2;               \
    *(bf16x8*)(K_lds + (b) * SHM_K + KSWZ(sr, kc_)) = sr_[i].ks0;                       \
    *(bf16x8*)(K_lds + (b) * SHM_K + KSWZ(32 + sr, kc_)) = sr_[i].ks1; } while (0)
#define SWAIT() do { if constexpr (SDEPTH == 2) asm volatile("s_waitcnt vmcnt(4)" ::: "memory"); else asm volatile("s_waitcnt vmcnt(0)" ::: "memory"); } while (0)
#define RESC(a) do { if (__any((a) < 1.f)) { if (hi == 0) al_l[r32] = (a); asm volatile("s_waitcnt lgkmcnt(0)" ::: "memory"); \
    _Pragma("unroll") for (int d = 0; d < 4; ++d) _Pragma("unroll") for (int r = 0; r < 16; ++r) o[d][r] *= al_l[crow(r, hi)]; } } while (0)
    f32x16 pA0, pA1, pB0, pB1; float mnA, mnB, alA, alB; bf16x8 pa0, pa1, pa2, pa3; const int NT = seq / KVBLK;
    constexpr int SE = 0, SO = SDEPTH - 1;
    SLOAD(SE, 0); asm volatile("s_waitcnt vmcnt(0)" ::: "memory"); SWRITE(0, SE); __syncthreads();
    qkt<8, 256>(pA0, pA1, K_lds, qr, r32, hi); partialSM(pA0, pA1, m_reg, mnA, alA);
    SLOAD(SO, KVBLK); if constexpr (SDEPTH == 2) { if (2 < NT) SLOAD(SE, 2 * KVBLK); }
    SWAIT(); SWRITE(1, SO); __syncthreads();
    for (int j = 1; j + 1 < NT; j += 2) {
        SBAR(); qkt<8, 256>(pB0, pB1, K_lds + SHM_K, qr, r32, hi);
        finishSM(pA0, pA1, alA, l_reg, pa0, pa1, pa2, pa3); SBAR();
        SLOAD(SO, (j + SDEPTH) * KVBLK); SBAR();
        pv_d0(o, vb0, pa0, pa1, pa2, pa3); partialSM(pB0, pB1, m_reg, mnB, alB);
        __syncthreads(); SWAIT(); SWRITE(0, SE);
        RESC(alB); __syncthreads();
        SBAR(); qkt<8, 256>(pA0, pA1, K_lds, qr, r32, hi);
        finishSM(pB0, pB1, alB, l_reg, pa0, pa1, pa2, pa3); SBAR();
        if (SDEPTH == 1 || j + 3 < NT) SLOAD(SE, (j + 1 + SDEPTH) * KVBLK); SBAR();
        pv_d0(o, vb0 + (int)SHM_V, pa0, pa1, pa2, pa3); partialSM(pA0, pA1, m_reg, mnA, alA);
        __syncthreads(); SWAIT(); SWRITE(1, SO);
        RESC(alA); __syncthreads();
    }
    SBAR(); qkt<8, 256>(pB0, pB1, K_lds + SHM_K, qr, r32, hi);
    finishSM(pA0, pA1, alA, l_reg, pa0, pa1, pa2, pa3); SBAR();
    pv_d0(o, vb0, pa0, pa1, pa2, pa3); partialSM(pB0, pB1, m_reg, mnB, alB);
    __syncthreads(); RESC(alB);
    finishSM(pB0, pB1, alB, l_reg, pa0, pa1, pa2, pa3); SBAR();
    pv_d0(o, vb0 + (int)SHM_V, pa0, pa1, pa2, pa3);
    if (hi == 0) li_l[r32] = l_reg; asm volatile("s_waitcnt lgkmcnt(0)" ::: "memory");
    float rli[16];
#pragma unroll
    for (int r = 0; r < 16; ++r) rli[r] = __builtin_amdgcn_rcpf(li_l[crow(r, hi)]);
    bf16* Ow = Ob + (long)(wid * QBLK) * LDO;
#pragma unroll
    for (int r = 0; r < 16; ++r) { const int orow = crow(r, hi);
#pragma unroll
        for (int d0 = 0; d0 < 4; ++d0) Ow[(long)orow * LDO + d0 * 32 + r32] = (bf16)f2bf(o[d0][r] * rli[r] * ATT_OUT_SCALE); }
    asm volatile("s_waitcnt lgkmcnt(0)" ::: "memory");
    __syncthreads();
#undef SLOAD
#undef SWRITE
#undef SWAIT
#undef RESC
}
__device__ __forceinline__ void rope_phase(Frame& F) {
    bf16* P = (bf16*)(F.ws + WS_PROJ);
    const float* qn = (const float*)F.in[8]; const float* kn = (const float*)F.in[9];
    const float* cosT = (const float*)(F.ws + WS_ROPE); const float* sinT = cosT + SEQ * 64;
    const float* part = (const float*)(F.ws + WS_PART);
    const int gw = blockIdx.x * NWAVES + F.wave, NGW = F.G * NWAVES, lane = F.lane;
    const float q0 = qn[2 * lane], q1 = qn[2 * lane + 1], k0 = kn[2 * lane], k1 = kn[2 * lane + 1];
    for (int tok = gw; tok < TOK; tok += NGW) {
        const int t = tok & (SEQ - 1);
        unsigned* p = (unsigned*)(P + (size_t)tok * APROJ) + lane;
        unsigned w[24];
#pragma unroll
        for (int hs = 0; hs < 24; ++hs) w[hs] = p[hs * 64];
        const float pp = lane < 32 ? part[(size_t)tok * 32 + lane] : 0.f;
        const float c = cosT[t * 64 + lane], s = sinT[t * 64 + lane];
        const float r2 = 1.0f / (wave_sum(pp) * (1.0f / DM) + NORM_EPS);
        const float rstd = sqrtf(r2), epsq = NORM_EPS / r2;
#pragma unroll
        for (int hs = 0; hs < 24; ++hs) {
            const float x1 = bf_lo(w[hs]), x2 = bf_hi(w[hs]);
            if (hs >= 20) { p[hs * 64] = cvtpk(x1 * rstd, x2 * rstd); continue; }
            const float rs = 1.0f / sqrtf(wave_sum(x1 * x1 + x2 * x2) * (1.0f / 128.0f) + epsq);
            const float y1 = x1 * rs * (hs < 16 ? q0 : k0), y2 = x2 * rs * (hs < 16 ? q1 : k1);
            p[hs * 64] = cvtpk(y1 * c - y2 * s, y1 * s + y2 * c);
        }
    }
}
__device__ __forceinline__ void phase(Frame& F) {
    const bf16* P = (const bf16*)(F.ws + WS_PROJ); bf16* OB = (bf16*)(F.ws + WS_HB);
    const int G = F.G; const int x = blockIdx.x & 7, jx = blockIdx.x >> 3, per = G >> 3;
    for (int u = (G % 8 == 0) ? (x * per + jx) : (int)blockIdx.x; u < 1024; u += G) {
        const int bk = u >> 5, hg = (u >> 3) & 3, qb = u & 7, b = bk >> 2, kvh = bk & 3, h = kvh * 4 + hg;
        const bf16* rowb = P + (size_t)(b * SEQ) * APROJ;
        attn_dense_body(rowb + (size_t)(qb * 256) * APROJ + h * D, rowb + 2048 + kvh * D, rowb + 2560 + kvh * D,
                        OB + (size_t)(b * SEQ + qb * 256) * DM + h * D, SEQ, (char*)F.lds);
    }
}
}
namespace tk {
constexpr int OFF_K1 = 0, OFF_K2 = 32768, OFF_SCR = 65536;
static_assert(OFF_SCR + NWAVES * 4096 <= RING_BYTES, "topk LDS");
__device__ __forceinline__ void ce(unsigned& a, unsigned& b) { const unsigned mx = a > b ? a : b, mn = a > b ? b : a; a = mx; b = mn; }
__device__ __forceinline__ void sort16(unsigned (&k)[16]) {
#pragma unroll
    for (int sz = 2; sz <= 16; sz <<= 1)
#pragma unroll
        for (int st = sz >> 1; st > 0; st >>= 1)
#pragma unroll
            for (int i = 0; i < 16; ++i) { const int j = i ^ st; if (j > i) { if ((i & sz) == 0) ce(k[i], k[j]); else ce(k[j], k[i]); } }
}
__device__ __forceinline__ void merge16(unsigned (&a)[16], const unsigned (&b)[16]) {
#pragma unroll
    for (int i = 0; i < 16; ++i) a[i] = a[i] > b[15 - i] ? a[i] : b[15 - i];
#pragma unroll
    for (int st = 8; st > 0; st >>= 1)
#pragma unroll
        for (int i = 0; i < 16; ++i) { const int j = i ^ st; if (j > i) ce(a[i], a[j]); }
}
__device__ __forceinline__ void xmerge16(unsigned (&a)[16]) {
    unsigned x[16], y[16];
#pragma unroll
    for (int i = 0; i < 16; ++i) { auto rr = __builtin_amdgcn_permlane32_swap(a[i], a[i], false, false); x[i] = rr[0]; y[i] = rr[1]; }
    merge16(x, y);
#pragma unroll
    for (int i = 0; i < 16; ++i) a[i] = x[i];
}
__device__ __forceinline__ unsigned f2key(float f) { const unsigned u = __float_as_uint(f); return u ^ ((unsigned)((int)u >> 31) | 0x80000000u); }
__device__ __forceinline__ float key2f(unsigned k, unsigned mask) { k &= ~mask; const unsigned u = (k & 0x80000000u) ? (k ^ 0x80000000u) : ~k; return __uint_as_float(u & ~mask); }
template <int VAR>
__device__ __forceinline__ void half_topk(unsigned (&t)[16], const bf16* qrow, const char* Kl, int r32, int hi) {
    bf16x8 qr[8];
#pragma unroll
    for (int d0 = 0; d0 < 8; ++d0) qr[d0] = *reinterpret_cast<const bf16x8*>(qrow + d0 * 16);
    f32x16 a0, a1, a2, a3;
    if (VAR != 3) { qkt<8, 256>(a0, a1, Kl, qr, r32, hi); qkt<8, 256>(a2, a3, Kl + 64 * 256, qr, r32, hi); }
    else { a0 = f32x16{}; a1 = a0; a2 = a0; a3 = a0; a0[0] = __uint_as_float((unsigned)qr[0][0]); a1[1] = __uint_as_float((unsigned)qr[7][1]); }
    unsigned kb[16], kc[16], kd[16];
#pragma unroll
    for (int r = 0; r < 16; ++r) { const unsigned base = 127u - (unsigned)((r & 3) + 8 * (r >> 2)) - 4u * (unsigned)hi;
        t[r]  = (f2key(a0[r]) & ~127u) | (base);
        kb[r] = (f2key(a1[r]) & ~127u) | (base - 32u);
        kc[r] = (f2key(a2[r]) & ~127u) | (base - 64u);
        kd[r] = (f2key(a3[r]) & ~127u) | (base - 96u); }
    if (VAR != 2) { sort16(t); sort16(kb); sort16(kc); sort16(kd);
    merge16(t, kb); merge16(kc, kd); merge16(t, kc);
    xmerge16(t); } else { for (int r = 0; r < 16; ++r) t[r] ^= kb[r] + kc[r] + kd[r]; }
}
struct Cand { int i, j; };
constexpr Cand cand_at(int n) {
    int c = 0;
    for (int i = 0; i < 16; ++i) for (int j = 0; j < 16; ++j) if ((i + 1) * (j + 1) <= 16) { if (c == n) return Cand{i, j}; ++c; }
    return Cand{0, 0};
}
template <int N> __device__ __forceinline__ unsigned cand_key(const float (&v1)[16], const float (&v2)[16], int hi) {
    constexpr Cand A = cand_at(N), B = cand_at(25 + N);
    const float s = hi ? (v1[B.i] + v2[B.j]) : (v1[A.i] + v2[A.j]);
    const unsigned pl = hi ? (unsigned)(B.i * 16 + B.j) : (unsigned)(A.i * 16 + A.j);
    return (f2key(s) & ~255u) | pl;
}
template <int N> struct CandFill { static __device__ __forceinline__ void run(unsigned (&c)[32], const float (&v1)[16], const float (&v2)[16], int hi) { c[N] = cand_key<N>(v1, v2, hi); CandFill<N + 1>::run(c, v1, v2, hi); } };
template <> struct CandFill<25> { static __device__ __forceinline__ void run(unsigned (&)[32], const float (&)[16], const float (&)[16], int) {} };
template <int VAR = 0>
__device__ __forceinline__ void phase(Frame& F, int layer, const bf16* PQ) {
    const int tid = F.tid, wid = F.wave, lane = F.lane, r32 = lane & 31, hi = lane >> 5;
    char* lds = (char*)F.lds;
    const bf16* pk = (const bf16*)(F.ws + WS_PK) + (size_t)layer * 2 * PKEYS * PHALF;
    const float* part = (const float*)(F.ws + WS_PART);
    int* idx_out = (int*)(F.ws + (VAR ? WS_PSCR : WS_IDX)); float* gate_out = (float*)(F.ws + (VAR ? WS_PSCR + 16 * MiB : WS_GSM));
    __syncthreads();
#pragma unroll
    for (int i = 0; i < 8; ++i) { const int c = tid + NTHREADS * i, which = c >> 11, rc = c & 2047, row = rc >> 4, ch = rc & 15;
        const u32x4 v = *(const u32x4*)(pk + (size_t)which * PKEYS * PHALF + row * PHALF + ch * 8);
        *(u32x4*)(lds + which * 32768 + row * 256 + ((ch * 16) ^ ((row & 7) << 4))) = v; }
    __syncthreads();
    int* scr = (int*)(lds + OFF_SCR + wid * 4096) + r32 * 32;
    for (int unit = blockIdx.x; unit < TOK / 32; unit += F.G) {
        const int tok = unit * 32 + r32, head = wid;
        const bf16* qrow = PQ + (size_t)tok * DM + head * 256 + hi * 8;
        unsigned t1[16], t2[16];
        half_topk<VAR>(t1, qrow, lds + OFF_K1, r32, hi);
        half_topk<VAR>(t2, qrow + PHALF, lds + OFF_K2, r32, hi);
        float v1[16], v2[16];
#pragma unroll
        for (int i = 0; i < 16; ++i) { v1[i] = key2f(t1[i], 127u); v2[i] = key2f(t2[i], 127u); }
        if (hi == 0) {
#pragma unroll
            for (int i = 0; i < 16; ++i) { scr[i] = 127 - (int)(t1[i] & 127u); scr[16 + i] = 127 - (int)(t2[i] & 127u); }
        }
        unsigned cc[32];
#pragma unroll
        for (int n = 25; n < 32; ++n) cc[n] = 0u;
        CandFill<0>::run(cc, v1, v2, hi);
        unsigned ca[16], cb[16];
#pragma unroll
        for (int n = 0; n < 16; ++n) { ca[n] = cc[n]; cb[n] = cc[16 + n]; }
        if (VAR != 2) { sort16(ca); sort16(cb); merge16(ca, cb); xmerge16(ca); } else { for (int n = 0; n < 16; ++n) ca[n] ^= cb[n]; }
        float ssq = 0.f;
#pragma unroll
        for (int q = 0; q < 8; ++q) { const f32x4 pp = *(const f32x4*)(part + (size_t)tok * 32 + q * 4); ssq += (pp[0] + pp[1]) + (pp[2] + pp[3]); }
        const float rstd = 1.0f / sqrtf(ssq * (1.0f / DM) + NORM_EPS);
        float e[16]; float esum = 0.f; const float top = key2f(ca[0], 255u);
#pragma unroll
        for (int k = 0; k < 16; ++k) { e[k] = __expf((key2f(ca[k], 255u) - top) * rstd); esum += e[k]; }
        const float inv = 1.0f / esum;
        asm volatile("s_waitcnt lgkmcnt(0)" ::: "memory");
        int eo[8]; float go[8];
#pragma unroll
        for (int k = 0; k < 8; ++k) { const unsigned key = hi ? ca[8 + k] : ca[k]; const int pl = (int)(key & 255u);
            eo[k] = scr[pl >> 4] * PKEYS + scr[16 + (pl & 15)]; go[k] = (hi ? e[8 + k] : e[k]) * inv; }
        unsigned* io = (unsigned*)idx_out + (size_t)tok * (PE / 2) + head * 8 + hi * 4; float* gg = gate_out + (size_t)tok * PE + head * 16 + hi * 8;
        *(u32x4*)io = (u32x4){(unsigned)eo[0] | ((unsigned)eo[1] << 16), (unsigned)eo[2] | ((unsigned)eo[3] << 16), (unsigned)eo[4] | ((unsigned)eo[5] << 16), (unsigned)eo[6] | ((unsigned)eo[7] << 16)};
        *(f32x4*)gg = (f32x4){go[0], go[1], go[2], go[3]}; *(f32x4*)(gg + 4) = (f32x4){go[4], go[5], go[6], go[7]};
        asm volatile("s_waitcnt lgkmcnt(0)" ::: "memory");
    }
    __syncthreads();
}
}

namespace pg {
__device__ __forceinline__ float gelu_tanh(float x) {
    const float u = 0.7978845608028654f * (x + 0.044715f * x * x * x);
    const float e = __expf(2.0f * u); const float th = 1.0f - 2.0f * __builtin_amdgcn_rcpf(e + 1.0f);
    return 0.5f * x * (1.0f + th);
}
struct Place { int ord, nx, lw, nlw; };
constexpr int NSL4 = 8, SLW4 = 256, SLB4 = 128;
typedef int i32x8 __attribute__((ext_vector_type(8)));
template <int VAR>
__device__ __forceinline__ void phase_u4(Frame& F, const Place& pl, int layer, const bf16* xbin, float* P) {
    const int lane = F.lane, j = lane >> 3, c = lane & 7, i16 = lane & 15, g = lane >> 4;
    const unsigned char* ub = (const unsigned char*)(F.ws + WS_UB) + (size_t)layer * PEXP * (DM / 2);
    const __amdgpu_buffer_rsrc_t irs = __builtin_amdgcn_make_buffer_rsrc((void*)(F.ws + WS_IDX), 0, TOK * PE * 2, 0x00020000);
    const __amdgpu_buffer_rsrc_t xrs = __builtin_amdgcn_make_buffer_rsrc((void*)xbin, 0, TOK * DM * 2, 0x00020000);
    const __amdgpu_buffer_rsrc_t prs = __builtin_amdgcn_make_buffer_rsrc((void*)P, 0, TOK * NSL4 * PE * 4, 0x00020000);
    const int bsrc = (j >> 1) * 4, bsh = (j & 1) * 16;
    const int tile = (int)(uintptr_t)((char*)F.lds) + F.wave * 16384, xs = (int)(uintptr_t)((char*)F.lds) + 131072 + F.wave * 256;
    const int wr0 = tile + j * 128 + ((c ^ (j >> 1)) * 16), wr1 = tile + j * 128 + ((c ^ (4 + (j >> 1))) * 16);
    const int ard0 = tile + i16 * 128 + ((g ^ (i16 >> 1)) * 16), ard1 = tile + i16 * 128 + (((4 + g) ^ (i16 >> 1)) * 16);
    for (int s = pl.ord; s < NSL4; s += pl.nx) {
        const __amdgpu_buffer_rsrc_t rs = __builtin_amdgcn_make_buffer_rsrc((void*)(ub + (size_t)s * PEXP * SLB4), 0, PEXP * SLB4, 0x00020000);
        u32x4 rA[16], rB[16]; u32x2 xA, xB;
        unsigned idwA = __builtin_amdgcn_raw_buffer_load_b32(irs, (pl.lw * (PE / 2) + lane) * 4, 0, 0), idwB = 0;
#define PU_ISSUE(r, xr, t, idw, idnext) do { __builtin_amdgcn_sched_barrier(0); \
            { const int tn_ = ((t) + pl.nlw < TOK) ? (t) + pl.nlw : (t); idnext = __builtin_amdgcn_raw_buffer_load_b32(irs, (tn_ * (PE / 2) + lane) * 4, 0, 0); } asm volatile("" ::: "memory"); \
            _Pragma("unroll") for (int b = 0; b < 16; ++b) { const int e_ = (int)((unsigned)__builtin_amdgcn_ds_bpermute(bsrc + 16 * b, (int)idw) >> bsh) & (VAR == 2 ? 0x3ff : 0xffff); \
                if (VAR == 3) r[b] = (u32x4){(unsigned)e_, 1u, 2u, 3u}; else r[b] = __builtin_amdgcn_raw_buffer_load_b128(rs, e_ * SLB4 + c * 16, 0, 0); } \
            xr = __builtin_amdgcn_raw_buffer_load_b64(xrs, ((t) * DM + s * SLW4 + 4 * lane) * 2, 0, 0); \
            asm volatile("" ::: "memory"); __builtin_amdgcn_sched_barrier(0); } while (0)
#define PU_MF(beta, ad, bq) { const u32x4 a_ = *(LAS u32x4*)(uintptr_t)(unsigned)((ad) + 2048 * (beta)); \
            acc[beta] = __builtin_amdgcn_mfma_scale_f32_16x16x128_f8f6f4((i32x8){(int)a_.x, (int)a_.y, (int)a_.z, (int)a_.w, 0, 0, 0, 0}, bq, acc[beta], 4, 0, 0, 0x7f7f7f7f, 0, 0x7f7f7f7f); }
#define PU_COMPUTE(r, xr, t, valid) do { \
            if (VAR == 1) { u32x4 z_ = r[0]; _Pragma("unroll") for (int b = 1; b < 16; ++b) z_ = z_ ^ r[b]; z_.x ^= xr.x ^ xr.y; \
                __builtin_amdgcn_raw_buffer_store_b128(z_, prs, (i16 < 8 && (valid)) ? (((t) * NSL4 + s) * PE + 16 * i16 + 4 * g) * 4 : 0x7ffffff0, 0, 0); break; } \
            _Pragma("unroll") for (int b = 0; b < 16; ++b) *(LAS u32x4*)(uintptr_t)(unsigned)(((b & 1) ? wr1 : wr0) + 1024 * b) = r[b]; \
            { const float x0 = __uint_as_float(xr.x << 16), x1 = __uint_as_float(xr.x & 0xffff0000u), x2 = __uint_as_float(xr.y << 16), x3 = __uint_as_float(xr.y & 0xffff0000u); \
              int pk = __builtin_amdgcn_cvt_pk_fp8_f32(__builtin_amdgcn_fmed3f(x0, -448.f, 448.f), __builtin_amdgcn_fmed3f(x1, -448.f, 448.f), 0, false); \
              pk = __builtin_amdgcn_cvt_pk_fp8_f32(__builtin_amdgcn_fmed3f(x2, -448.f, 448.f), __builtin_amdgcn_fmed3f(x3, -448.f, 448.f), pk, true); \
              *(LAS unsigned*)(uintptr_t)(unsigned)(xs + 4 * lane) = (unsigned)pk; } \
              \
            const u32x4 b00 = *(LAS u32x4*)(uintptr_t)(unsigned)(xs + 16 * g), b01 = *(LAS u32x4*)(uintptr_t)(unsigned)(xs + 64 + 16 * g); \
            const u32x4 b10 = *(LAS u32x4*)(uintptr_t)(unsigned)(xs + 128 + 16 * g), b11 = *(LAS u32x4*)(uintptr_t)(unsigned)(xs + 192 + 16 * g); \
            const i32x8 bq0 = {(int)b00.x, (int)b00.y, (int)b00.z, (int)b00.w, (int)b01.x, (int)b01.y, (int)b01.z, (int)b01.w}; \
            const i32x8 bq1 = {(int)b10.x, (int)b10.y, (int)b10.z, (int)b10.w, (int)b11.x, (int)b11.y, (int)b11.z, (int)b11.w}; \
            f32x4 acc[8]; \
            _Pragma("unroll") for (int be = 0; be < 8; ++be) acc[be] = (f32x4){0.f, 0.f, 0.f, 0.f}; \
            _Pragma("unroll") for (int be = 0; be < 8; ++be) PU_MF(be, ard0, bq0) \
            _Pragma("unroll") for (int be = 0; be < 8; ++be) PU_MF(be, ard1, bq1) \
            f32x4 o_ = acc[0]; \
            _Pragma("unroll") for (int be = 1; be < 8; ++be) { const bool m_ = (i16 == be); o_[0] = m_ ? acc[be][0] : o_[0]; o_[1] = m_ ? acc[be][1] : o_[1]; o_[2] = m_ ? acc[be][2] : o_[2]; o_[3] = m_ ? acc[be][3] : o_[3]; } \
            __builtin_amdgcn_raw_buffer_store_b128((u32x4){__float_as_uint(o_[0]), __float_as_uint(o_[1]), __float_as_uint(o_[2]), __float_as_uint(o_[3])}, prs, \
                                                   (i16 < 8 && (valid)) ? (((t) * NSL4 + s) * PE + 16 * i16 + 4 * g) * 4 : 0x7ffffff0, 0, 0);        \
            asm volatile("s_waitcnt lgkmcnt(0)" ::: "memory"); } while (0)
        PU_ISSUE(rA, xA, pl.lw, idwA, idwB);
        for (int t = pl.lw; t < TOK; t += 2 * pl.nlw) {
            const bool vB = t + pl.nlw < TOK; const int tB = vB ? t + pl.nlw : t, tA2 = (t + 2 * pl.nlw < TOK) ? t + 2 * pl.nlw : t;
            PU_ISSUE(rB, xB, tB, idwB, idwA);
            PU_COMPUTE(rA, xA, t, true);
            PU_ISSUE(rA, xA, tA2, idwA, idwB);
            PU_COMPUTE(rB, xB, tB, vB);
        }
#undef PU_ISSUE
#undef PU_MF
#undef PU_COMPUTE
    }
}
template <int NSLU, int U4>
__device__ __forceinline__ void phase_r(Frame& F, const float* P) {
    const int lane = F.lane, l32 = lane & 31;
    const float* part = (const float*)(F.ws + WS_PART); const float* gate = (const float*)(F.ws + WS_GSM); float* wout = (float*)(F.ws + WS_HB);
    const int gw = blockIdx.x * NWAVES + F.wave, NGW = F.G * NWAVES;
    for (int t0 = gw; t0 < TOK; t0 += 2 * NGW) {
        const int t1 = (t0 + NGW < TOK) ? t0 + NGW : t0;
        f32x4 v[2][NSLU / 2]; float pp[2]; f32x4 g[2];
#pragma unroll
        for (int u = 0; u < 2; ++u) { const int t = u ? t1 : t0;
            const f32x4* base = (const f32x4*)(P + (size_t)t * NSLU * PE) + lane;
#pragma unroll
            for (int i = 0; i < NSLU / 2; ++i) v[u][i] = base[64 * i];
            pp[u] = lane < 32 ? part[(size_t)t * 32 + lane] : 0.f;
            g[u] = *(const f32x4*)(gate + (size_t)t * PE + l32 * 4); }
#pragma unroll
        for (int u = 0; u < 2; ++u) { const int t = u ? t1 : t0;
            const float rstd = (1.0f / (U4 ? PEER_U4_SCALE : PEER_U_SCALE)) / sqrtf(wave_sum(pp[u]) * (1.0f / DM) + NORM_EPS);
            f32x4 a = v[u][0];
#pragma unroll
            for (int i = 1; i < NSLU / 2; ++i) a += v[u][i];
            a[0] += __shfl_xor(a[0], 32); a[1] += __shfl_xor(a[1], 32); a[2] += __shfl_xor(a[2], 32); a[3] += __shfl_xor(a[3], 32);
            const float vs = 1.0f / PEER_V_SCALE;
            const f32x4 w = {vs * g[u][0] * gelu_tanh(a[0] * rstd), vs * g[u][1] * gelu_tanh(a[1] * rstd), vs * g[u][2] * gelu_tanh(a[2] * rstd), vs * g[u][3] * gelu_tanh(a[3] * rstd)};
            if (lane < 32 && (u == 0 || t1 != t0)) {
                const u32x2 ids = *(const u32x2*)((const unsigned*)(F.ws + WS_IDX) + (size_t)t * (PE / 2) + l32 * 2);
                const unsigned w01 = cvtpk(w[0], w[1]), w23 = cvtpk(w[2], w[3]);
                *(u32x4*)((unsigned*)wout + (size_t)t * PE + l32 * 4) = (u32x4){(w01 << 16) | (ids.x & 0xffffu), (w01 & 0xffff0000u) | (ids.x >> 16), (w23 << 16) | (ids.y & 0xffffu), (w23 & 0xffff0000u) | (ids.y >> 16)};
                { const float ws_ = PEER_V_SCALE * PEER_W_SCALE;
                  int pk = __builtin_amdgcn_cvt_pk_fp8_f32(fminf(fmaxf(w[0] * ws_, -448.f), 448.f), fminf(fmaxf(w[1] * ws_, -448.f), 448.f), 0, false);
                  pk = __builtin_amdgcn_cvt_pk_fp8_f32(fminf(fmaxf(w[2] * ws_, -448.f), 448.f), fminf(fmaxf(w[3] * ws_, -448.f), 448.f), pk, true);
                  *(unsigned*)((unsigned char*)(F.ws + WS_HB + 8 * MiB) + (size_t)t * PE + l32 * 4) = (unsigned)pk; } } }
    }
}
constexpr float PEER_V4_SCALE = 5.656854249f;
__device__ __forceinline__ void phase_v4(Frame& F, const Place& pl, int layer, const bf16* xin, float* xout, bf16* xbout, float* part2) {
    const int lane = F.lane, j = lane >> 3, c = lane & 7, n16 = lane & 15, g = lane >> 4;
    const unsigned char* vb = (const unsigned char*)(F.ws + WS_VB) + (size_t)layer * PEXP * (DM / 2);
    const __amdgpu_buffer_rsrc_t wrs = __builtin_amdgcn_make_buffer_rsrc((void*)(F.ws + WS_HB), 0, TOK * PE * 4, 0x00020000);
    const __amdgpu_buffer_rsrc_t frs = __builtin_amdgcn_make_buffer_rsrc((void*)(F.ws + WS_HB + 8 * MiB), 0, TOK * PE, 0x00020000);
    const __amdgpu_buffer_rsrc_t xirs = __builtin_amdgcn_make_buffer_rsrc((void*)xin, 0, TOK * DM * 2, 0x00020000);
    const __amdgpu_buffer_rsrc_t xors = __builtin_amdgcn_make_buffer_rsrc((void*)(xout ? (void*)xout : (void*)xin), 0, xout ? TOK * DM * 4 : 0, 0x00020000);
    const __amdgpu_buffer_rsrc_t xbrs = __builtin_amdgcn_make_buffer_rsrc((void*)(xbout ? (void*)xbout : (void*)xin), 0, xbout ? TOK * DM * 2 : 0, 0x00020000);
    const __amdgpu_buffer_rsrc_t p2rs = __builtin_amdgcn_make_buffer_rsrc((void*)(part2 ? (void*)part2 : (void*)xin), 0, part2 ? TOK * 32 * 4 : 0, 0x00020000);
    const int bsrc = j * 4;
    const int tile = (int)(uintptr_t)((char*)F.lds) + F.wave * 16384;
    const int wr0 = tile + j * 128 + ((c ^ (j >> 1)) * 16), wr1 = tile + j * 128 + ((c ^ (4 + (j >> 1))) * 16);
    const int trb = (tile + (32 * g + n16) * 128) | ((2 * ((n16 >> 1) & 7) + (g & 1)) * 8);
    for (int s = pl.ord; s < NSL4; s += pl.nx) {
        const __amdgpu_buffer_rsrc_t rs = __builtin_amdgcn_make_buffer_rsrc((void*)(vb + (size_t)s * PEXP * SLB4), 0, PEXP * SLB4, 0x00020000);
        u32x4 rA[16], rB[16], wA0, wA1, wB0, wB1; u32x2 resA, resB;
        unsigned cwA0 = __builtin_amdgcn_raw_buffer_load_b32(wrs, (pl.lw * PE + lane) * 4, 0, 0), cwA1 = __builtin_amdgcn_raw_buffer_load_b32(wrs, (pl.lw * PE + 64 + lane) * 4, 0, 0), cwB0 = 0, cwB1 = 0;
#define PV_ISSUE(r, w0, w1, res, t, cw0, cw1, cn0, cn1) do { __builtin_amdgcn_sched_barrier(0); \
            { const int tn_ = ((t) + pl.nlw < TOK) ? (t) + pl.nlw : (t); cn0 = __builtin_amdgcn_raw_buffer_load_b32(wrs, (tn_ * PE + lane) * 4, 0, 0); cn1 = __builtin_amdgcn_raw_buffer_load_b32(wrs, (tn_ * PE + 64 + lane) * 4, 0, 0); } asm volatile("" ::: "memory"); \
            _Pragma("unroll") for (int b = 0; b < 16; ++b) { const unsigned cwp_ = (unsigned)__builtin_amdgcn_ds_bpermute(bsrc + 32 * (b & 7), (int)(b < 8 ? cw0 : cw1)); \
                r[b] = __builtin_amdgcn_raw_buffer_load_b128(rs, (int)(cwp_ & 0xffffu) * SLB4 + c * 16, 0, 0); } \
            w0 = __builtin_amdgcn_raw_buffer_load_b128(frs, (t) * PE + 16 * g, 0, 0); w1 = __builtin_amdgcn_raw_buffer_load_b128(frs, (t) * PE + 64 + 16 * g, 0, 0); \
            res = __builtin_amdgcn_raw_buffer_load_b64(xirs, ((t) * DM + s * SLW4 + 64 * g + 4 * n16) * 2, 0, 0); \
            asm volatile("" ::: "memory"); __builtin_amdgcn_sched_barrier(0); } while (0)
#define PV_TR(cb, hf, dst) asm volatile("ds_read_b64_tr_b4 %0, %1 offset:%2" : "=&v"(dst) : "v"(trb_ ^ ((cb) * 8)), "i"((hf) * 2048) : "memory")
#define PV_MF(k, lo, hi) acc[k] = __builtin_amdgcn_mfma_scale_f32_16x16x128_f8f6f4(aw_, (i32x8){(int)lo[0], (int)lo[1], (int)hi[0], (int)hi[1], 0, 0, 0, 0}, acc[k], 0, 4, 0, 0x7f7f7f7f, 0, 0x7f7f7f7f)
#define PV_HALF(hh, s0_, s1_) { s0_ = 0.f; s1_ = 0.f; \
            _Pragma("unroll") for (int kk = 0; kk < 2; ++kk) { u32x2 l0, h0, l1, h1, l2, h2, l3, h3; f32x4 acc[4]; \
                _Pragma("unroll") for (int k = 0; k < 4; ++k) acc[k] = (f32x4){0.f, 0.f, 0.f, 0.f}; \
                PV_TR(8 * hh + 4 * kk + 0, 0, l0); PV_TR(8 * hh + 4 * kk + 0, 1, h0); PV_TR(8 * hh + 4 * kk + 1, 0, l1); PV_TR(8 * hh + 4 * kk + 1, 1, h1); \
                PV_TR(8 * hh + 4 * kk + 2, 0, l2); PV_TR(8 * hh + 4 * kk + 2, 1, h2); PV_TR(8 * hh + 4 * kk + 3, 0, l3); PV_TR(8 * hh + 4 * kk + 3, 1, h3); \
                asm volatile("s_waitcnt lgkmcnt(0)" ::: "memory"); SBAR(); \
                PV_MF(0, l0, h0); PV_MF(1, l1, h1); PV_MF(2, l2, h2); PV_MF(3, l3, h3); \
                asm volatile("" : "+v"(acc[0][0]), "+v"(acc[1][0]), "+v"(acc[2][0]), "+v"(acc[3][0]) : "v"(l0), "v"(h0), "v"(l1), "v"(h1), "v"(l2), "v"(h2), "v"(l3), "v"(h3)); \
                s0_ = (g == 2 * kk) ? acc[0][0] : s0_; s1_ = (g == 2 * kk) ? acc[1][0] : s1_; s0_ = (g == 2 * kk + 1) ? acc[2][0] : s0_; s1_ = (g == 2 * kk + 1) ? acc[3][0] : s1_; } }
#define PV_COMPUTE(r, w0, w1, res, t, valid) do { \
            _Pragma("unroll") for (int b = 0; b < 16; ++b) { const int ad_ = ((b & 1) ? wr1 : wr0) + 1024 * b; \
                if ((b >> 2) & 1) { *(LAS u32x2*)(uintptr_t)(unsigned)(ad_ + 8) = (u32x2){r[b].x, r[b].y}; *(LAS u32x2*)(uintptr_t)(unsigned)(ad_) = (u32x2){r[b].z, r[b].w}; } \
                else *(LAS u32x4*)(uintptr_t)(unsigned)(ad_) = r[b]; } \
            asm volatile("s_waitcnt lgkmcnt(0)" ::: "memory"); \
            int trb_ = trb; asm volatile("" : "+v"(trb_));            \
            const i32x8 aw_ = {(int)w0.x, (int)w0.y, (int)w0.z, (int)w0.w, (int)w1.x, (int)w1.y, (int)w1.z, (int)w1.w}; \
            float q0, q1, q2, q3; \
            PV_HALF(0, q0, q1) PV_HALF(1, q2, q3) \
            const float sc_ = 1.0f / (PEER_V4_SCALE * PEER_W_SCALE); \
              \
            const float v0 = fmaf(q0, sc_, __uint_as_float(res.x << 16)), v1 = fmaf(q1, sc_, __uint_as_float(res.x & 0xffff0000u)), v2 = fmaf(q2, sc_, __uint_as_float(res.y << 16)), v3 = fmaf(q3, sc_, __uint_as_float(res.y & 0xffff0000u)); \
            const int o_ = (valid) ? (t) * DM + s * SLW4 + 64 * g + 4 * n16 : 0x0ffffff0; \
            __builtin_amdgcn_raw_buffer_store_b128((u32x4){__float_as_uint(v0), __float_as_uint(v1), __float_as_uint(v2), __float_as_uint(v3)}, xors, o_ * 4, 0, 0); \
            __builtin_amdgcn_raw_buffer_store_b64((u32x2){cvtpk(v0, v1), cvtpk(v2, v3)}, xbrs, o_ * 2, 0, 0); \
            if (part2) { const float ss = row_sum16((v0 * v0 + v1 * v1) + (v2 * v2 + v3 * v3));            \
                __builtin_amdgcn_raw_buffer_store_b32(__float_as_uint(ss), p2rs, (n16 == 0 && (valid)) ? ((t) * 32 + s + 8 * g) * 4 : 0x7ffffff0, 0, 0); } \
            asm volatile("s_waitcnt lgkmcnt(0)" ::: "memory"); } while (0)
        PV_ISSUE(rA, wA0, wA1, resA, pl.lw, cwA0, cwA1, cwB0, cwB1);
        for (int t = pl.lw; t < TOK; t += 2 * pl.nlw) {
            const bool vB = t + pl.nlw < TOK; const int tB = vB ? t + pl.nlw : t, tA2 = (t + 2 * pl.nlw < TOK) ? t + 2 * pl.nlw : t;
            PV_ISSUE(rB, wB0, wB1, resB, tB, cwB0, cwB1, cwA0, cwA1);
            PV_COMPUTE(rA, wA0, wA1, resA, t, true);
            PV_ISSUE(rA, wA0, wA1, resA, tA2, cwA0, cwA1, cwB0, cwB1);
            PV_COMPUTE(rB, wB0, wB1, resB, tB, vB);
        }
#undef PV_ISSUE
#undef PV_TR
#undef PV_MF
#undef PV_HALF
#undef PV_COMPUTE
    }
}
}
#ifndef REP_MASK
#define REP_MASK 0
#endif
#if REP_MASK == 0
#define REPS(i) if (constexpr int rep_ = 0; true)
#else
#define REPS(i) for (int rep_ = 0; rep_ < 1 + ((REP_MASK >> (i)) & 1); ++rep_)
#endif
#ifndef DBG_STAGE
#define DBG_STAGE 0
#endif
struct Args { const float* in[16]; float* out; unsigned char* ws; int pad0, pad1; };
__global__ void __launch_bounds__(NTHREADS, 2) fwd_megakernel(Args args) {
    extern __shared__ __attribute__((aligned(16))) unsigned char lds[];
    cg::grid_group grid = cg::this_grid();
    Frame F;
    F.lds = (LAS unsigned char*)lds;
    F.MISC = (volatile LAS unsigned*)(F.lds + MISC_OFF);
    F.tid = threadIdx.x; F.lane = F.tid & 63; F.wave = __builtin_amdgcn_readfirstlane(F.tid >> 6);
    F.G = gridDim.x; F.ws = (GAS unsigned char*)args.ws; F.out = (GAS float*)args.out;
#pragma unroll
    for (int i = 0; i < 16; ++i) F.in[i] = (const GAS float*)args.in[i];
    F.ctl = (gu32*)((GAS unsigned char*)args.ws + WS_CTL);
    for (int u = F.tid; u < (LDS_BYTES - LDSCTL_OFF) / 4; u += NTHREADS) ((LAS unsigned*)(F.lds + LDSCTL_OFF))[u] = 0u;
    __syncthreads();
    XcdBarrier bar = xcd_barrier_post((unsigned*)(F.ctl + CW_BAR), F.MISC + 8);
    if (F.tid == 0) F.MISC[10] = xb_add((unsigned*)(F.ctl + CW_RANK + 64 * bar.x), 1u);
#define GRID_BAR() do { xcd_barrier(bar); PHASE_BEGIN(); } while (0)
#define PLACE() pg::Place{(int)F.MISC[12], (int)F.MISC[11], (int)F.MISC[10] * NWAVES + F.wave, (int)F.MISC[13] * NWAVES}
#define PBUF ((float*)(ws + WS_PROJ))
#define PHASE_BEGIN() do { const int t_ = opaque_tid(); F.tid = t_; F.lane = t_ & 63; F.wave = __builtin_amdgcn_readfirstlane(t_ >> 6); GAS unsigned char* w_ = (GAS unsigned char*)args.ws; asm volatile("" : "+s"(w_)); ws = w_; F.ws = ws; } while (0)
    GAS unsigned char* ws = (GAS unsigned char*)args.ws;
#define XB0 ((bf16*)(ws + WS_XB0))
#define XB1 ((bf16*)(ws + WS_XB1))
#define XR ((float*)(ws + WS_XR))
#define PROJ ((bf16*)(ws + WS_PROJ))
#define PQ ((bf16*)(ws + WS_HS))
#define HB ((bf16*)(ws + WS_HB))
#define PART ((float*)(ws + WS_PART))
#define rstd0 ((float*)(ws + WS_RSTD))
#define rstd2 ((float*)(ws + WS_RSTD) + TOK)
    const int bid = (int)blockIdx.x;
    constexpr int STG = DBG_STAGE;

    REPS(0) { p0_prologue(F); VM_WAIT(); __syncthreads(); if (rep_ == 0) grid.sync(); else xcd_barrier(bar); PHASE_BEGIN(); }
    if (F.tid == 0) {
        unsigned nx = 0, ord = 0, nloc = 1;
        for (unsigned j = 0; j < 16; ++j) { const unsigned cnt = xb_ld((unsigned*)(F.ctl + CW_BAR) + XB_XCNT(j)); if (cnt) { if (j < bar.x) ++ord; ++nx; } if (j == bar.x) nloc = cnt ? cnt : 1; }
        F.MISC[11] = nx ? nx : 1; F.MISC[12] = ord; F.MISC[13] = nloc;
    }
    __syncthreads();
    if (STG >= 0) {
REPS(1) {
        if (bid < 64) ml::scan(F, bid >> 1, bid & 1);
    {
        pg8::Gemm g{XB0, (const bf16*)(ws + WS_WIN), TOK, MPROJ, DM}; pg8::StaticOrder S; S.init(TOK, MPROJ, F.G, bid);
        pg8::EpiScaleBf16 E{PROJ, MPROJ, rstd0, 4096};
        pg8::gemm_phase<pg8::EpiScaleBf16, pg8::StaticOrder, PG8_ALIGN, PG8_SP2>(F.lds, g, S, E);
    }
    GRID_BAR();
    }
#ifdef REP_BAR
    for (int rb_ = 0; rb_ < REP_BAR; ++rb_) GRID_BAR();
#endif
REPS(2) {
        ml2::phase<0>(F);
#ifdef ML_PROBE
        xcd_barrier(bar); PHASE_BEGIN(); ml2::phase<ML_PROBE + 1>(F);
#endif
    GRID_BAR();
    }
REPS(4) {
        {
        pg8::Gemm g{HB, (const bf16*)(ws + WS_WOUT), TOK, DM, DM}; pg8::StaticOrder S; S.init(TOK, DM, F.G, bid);
        pg8::EpiResidT<false, STG == 1> E{(const void*)F.in[0], XR, XB1, PART, DM};
        pg8::gemm_phase<pg8::EpiResidT<false, STG == 1>, pg8::StaticOrder, PG8_ALIGN, PG8_SP2>(F.lds, g, S, E);
    }
    GRID_BAR();
    }
    if (STG == 0 || STG >= 2) {
REPS(5) {
        {
        pg8::Gemm g{XB1, (const bf16*)(ws + WS_WQ), TOK, DM, DM}; pg8::StaticOrder S; S.init(TOK, DM, F.G, bid);
        pg8::EpiScaleBf16 E{PQ, DM, nullptr, 1 << 30};
        pg8::gemm_phase<pg8::EpiScaleBf16, pg8::StaticOrder, PG8_ALIGN, PG8_SP2>(F.lds, g, S, E);
    }
    GRID_BAR();
    }
REPS(6) {
        tk::phase<0>(F, 0, PQ);
#ifdef TK_PROBE
    xcd_barrier(bar); PHASE_BEGIN(); tk::phase<TK_PROBE + 1>(F, 0, PQ);
#endif
    GRID_BAR();
    }
REPS(7) { const pg::Place pl = PLACE(); pg::phase_u4<0>(F, pl, 0, XB1, PBUF); GRID_BAR(); }
#ifdef PU_PROBE
    { const pg::Place pl = PLACE(); pg::phase_u4<PU_PROBE>(F, pl, 0, XB1, (float*)(ws + WS_PSCR)); GRID_BAR(); }
#endif
    REPS(15) { pg::phase_r<pg::NSL4, 1>(F, PBUF); GRID_BAR(); }
    REPS(16) {
        { const pg::Place pl = PLACE(); pg::phase_v4(F, pl, 0, XB1, nullptr, XB0, PART); }
    GRID_BAR();
    }
    if (STG == 0 || STG >= 3) {
REPS(8) {
        {
        pg8::Gemm g{XB0, (const bf16*)(ws + WS_AIN), TOK, APROJ, DM}; pg8::StaticOrder S; S.init(TOK, APROJ, F.G, bid);
        pg8::EpiScaleBf16 E{PROJ, APROJ, nullptr, 1 << 30};
        pg8::gemm_phase<pg8::EpiScaleBf16, pg8::StaticOrder, PG8_ALIGN, PG8_SP2>(F.lds, g, S, E);
    }
    GRID_BAR();
    }
    at::rope_phase(F);
    GRID_BAR();
REPS(10) {
        at::phase(F);
    GRID_BAR();
    }
REPS(11) {
        {
        pg8::Gemm g{HB, (const bf16*)(ws + WS_AOUT), TOK, DM, DM}; pg8::StaticOrder S; S.init(TOK, DM, F.G, bid);
        pg8::EpiResidT<true, STG == 3> E{(const void*)XB0, XR, XB1, PART, DM};
        pg8::gemm_phase<pg8::EpiResidT<true, STG == 3>, pg8::StaticOrder, PG8_ALIGN, PG8_SP2>(F.lds, g, S, E);
    }
    GRID_BAR();
    }
    if (STG == 0) {
REPS(12) {
        {
        pg8::Gemm g{XB1, (const bf16*)(ws + WS_WQ) + (size_t)DM * DM, TOK, DM, DM}; pg8::StaticOrder S; S.init(TOK, DM, F.G, bid);
        pg8::EpiScaleBf16 E{PQ, DM, nullptr, 1 << 30};
        pg8::gemm_phase<pg8::EpiScaleBf16, pg8::StaticOrder, PG8_ALIGN, PG8_SP2>(F.lds, g, S, E);
    }
    GRID_BAR();
    }
REPS(13) {
        tk::phase<0>(F, 1, PQ);
    GRID_BAR();
    }
    REPS(14) { const pg::Place pl = PLACE(); pg::phase_u4<0>(F, pl, 1, XB1, PBUF); GRID_BAR(); }
    REPS(17) { pg::phase_r<pg::NSL4, 1>(F, PBUF); GRID_BAR(); }
    REPS(18) { { const pg::Place pl = PLACE(); pg::phase_v4(F, pl, 1, XB1, (float*)F.out, nullptr, nullptr); } if (rep_ + 1 < 1 + ((REP_MASK >> 18) & 1)) GRID_BAR(); }
    }
    }
    }
    }
#if DBG_STAGE == 1 || DBG_STAGE == 3 || DBG_STAGE == -1
    {
        const float* src = (DBG_STAGE == -1) ? (const float*)F.in[0] : (const float*)XR;
        const size_t gtid = (size_t)blockIdx.x * NTHREADS + F.tid, gthreads = (size_t)F.G * NTHREADS;
        for (size_t i = gtid; i < (size_t)TOK * DM / 4; i += gthreads) ((f32x4*)F.out)[i] = ((const f32x4*)src)[i];
    }
#endif
}

extern "C" void kernel_launch(void* const* d_in, const int* in_sizes, int n_in, void* d_out, int out_size, void* d_ws, size_t ws_size, hipStream_t stream) {
    static int grid = 0;
    if (grid == 0) {
        if (n_in != 16 || in_sizes[0] != TOK * DM || out_size != TOK * DM || ws_size < WS_END) {
            fprintf(stderr, "kernel_launch: unexpected shapes: n_in %d in0 %d out %d ws %zu (need >= %zu)\n", n_in, n_in > 0 ? in_sizes[0] : -1, out_size, ws_size, (size_t)WS_END); grid = -1; return; }
        int dev = 0, cus = 0, per_cu = 0;
        if (hipGetDevice(&dev) != hipSuccess || hipDeviceGetAttribute(&cus, hipDeviceAttributeMultiprocessorCount, dev) != hipSuccess) { fprintf(stderr, "kernel_launch: device query failed\n"); grid = -1; return; }
        if (hipFuncSetAttribute((const void*)fwd_megakernel, hipFuncAttributeMaxDynamicSharedMemorySize, LDS_BYTES) != hipSuccess) { fprintf(stderr, "kernel_launch: hipFuncSetAttribute failed\n"); grid = -1; return; }
        if (hipOccupancyMaxActiveBlocksPerMultiprocessor(&per_cu, (const void*)fwd_megakernel, NTHREADS, LDS_BYTES) != hipSuccess || per_cu < 1) {
            fprintf(stderr, "kernel_launch: occupancy query reports %d workgroups per CU\n", per_cu); (void)hipGetLastError(); per_cu = 1; }
        grid = cus;
        fprintf(stderr, "kernel_launch: %d CUs, occupancy %d per CU, grid %d\n", cus, per_cu, grid);
    }
    if (grid < 0) return;
    if (hipMemsetAsync((char*)d_ws + WS_CTL, 0, CTL_ZERO_BYTES, stream) != hipSuccess) { fprintf(stderr, "kernel_launch: memset failed\n"); return; }
    Args a{};
    for (int i = 0; i < 16; ++i) a.in[i] = (const float*)d_in[i];
    a.out = (float*)d_out; a.ws = (unsigned char*)d_ws;
    void* kargs[] = {&a};
    const hipError_t e = hipLaunchCooperativeKernel((const void*)fwd_megakernel, dim3(grid), dim3(NTHREADS), kargs, LDS_BYTES, stream);
    if (e != hipSuccess) fprintf(stderr, "kernel_launch: cooperative launch failed: %s (grid %d)\n", hipGetErrorString(e), grid);
}
```

```cpp
#include <hip/hip_runtime.h>
#include <hip/hip_cooperative_groups.h>
#include <cstdio>
#include <cstdint>
namespace cg = cooperative_groups;
#ifndef PG8_WGM
#define PG8_WGM 4
#endif
namespace pg8 {
#define PG8_LAS __attribute__((address_space(3)))
typedef unsigned short bf16_t;
typedef short bf16x8 __attribute__((ext_vector_type(8)));
typedef float f32x4 __attribute__((ext_vector_type(4)));
typedef unsigned u32x4 __attribute__((ext_vector_type(4)));
constexpr int BM = 256, BK = 64, HALF = 128, HTB = HALF * BK * 2  , STAGE_BYTES = 8 * HTB, NXCD = 8, WGM = PG8_WGM;

__host__ __device__ __forceinline__ int lds_byte(int r, int c) { const int st = (r >> 4) * 2 + (c >> 5), rr = r & 15, cc = c & 31, ob = rr * 64 + cc * 2; return st * 1024 + (ob ^ (((ob >> 9) & 1) << 5)); }
__host__ __device__ __forceinline__ void stage_rc(int b, int& R, int& C) { const int st = b / 1024, sb = b % 1024, swz = sb ^ (((sb >> 9) & 1) << 5); R = (st >> 1) * 16 + swz / 64; C = (st & 1) * 32 + (swz % 64) / 2; }
__host__ __device__ __forceinline__ int perm32(int rho) { const int n = rho >> 4, i = rho & 15; return 8 * (i >> 2) + 4 * n + (i & 3); }

struct Unit { int pm, pn; };
struct Gemm { const bf16_t* A; const bf16_t* Bt; int M, N, K; };

struct StaticOrder {
    int nM, nN, nwg, G, c, wgm;
    __host__ __device__ void init(int M, int N, int G_, int c_, int wgm_ = WGM) { nM = M / BM; nN = N / BM; nwg = nM * nN; G = G_; c = c_; wgm = wgm_; }
    __host__ __device__ bool next(int i, Unit& u) const {
        const long L = (long)i * G + c; if (L >= nwg) return false;
        int wgid = (int)L; { const int q = nwg / NXCD, r = nwg % NXCD, xcd = wgid % NXCD, off = wgid / NXCD; wgid = (xcd < r ? xcd * (q + 1) : r * (q + 1) + (xcd - r) * q) + off; }
        const int nig = wgm * nN, gid = wgid / nig, fm = gid * wgm, gsz = (nM - fm) < wgm ? (nM - fm) : wgm;
        u.pm = fm + ((wgid % nig) % gsz); u.pn = (wgid % nig) / gsz; return true;
    }
    __device__ __forceinline__ void a_ready(const Unit&) const {}
    __device__ __forceinline__ void done(const Unit&) const {}
};

__device__ __forceinline__ unsigned cvt_pk_bf16(float lo, float hi) { unsigned r; asm volatile("v_cvt_pk_bf16_f32 %0, %1, %2" : "=v"(r) : "v"(lo), "v"(hi)); return r; }
__device__ __forceinline__ float sigmoid_f(float x) { return __builtin_amdgcn_rcpf(1.0f + __expf(-x)); }
struct EpiScaleBf16 {
    static constexpr bool PERM = true, AFTER_DRAIN = false;
    bf16_t* O; int ldc; const float* rs; int sig_from;
    __device__ __forceinline__ void operator()(const f32x4 (&acc)[2][2][4][2], const Unit& u, int wr, int wc, int fr, int fq) const {
        const int row0 = u.pm * BM + wr * 64 + fr; const int col0 = u.pn * BM + wc * 32 + 8 * fq;
        const bool sg = (u.pn * BM) >= sig_from;
        float sv[8];
#pragma unroll
        for (int k = 0; k < 8; ++k) sv[k] = rs ? rs[row0 + (k >> 2) * HALF + (k & 3) * 16] : 1.0f;
#pragma unroll
        for (int ai = 0; ai < 2; ++ai)
#pragma unroll
            for (int m = 0; m < 4; ++m) { const int r = row0 + ai * HALF + m * 16; const float s = sv[ai * 4 + m]; bf16_t* rowp = O + (size_t)r * ldc + col0;
#pragma unroll
                for (int bj = 0; bj < 2; ++bj) { f32x4 v0 = acc[ai][bj][m][0] * s, v1 = acc[ai][bj][m][1] * s;
                    if (sg) { v0 = (f32x4){sigmoid_f(v0[0]), sigmoid_f(v0[1]), sigmoid_f(v0[2]), sigmoid_f(v0[3])}; v1 = (f32x4){sigmoid_f(v1[0]), sigmoid_f(v1[1]), sigmoid_f(v1[2]), sigmoid_f(v1[3])}; }
                    u32x4 w; w.x = cvt_pk_bf16(v0[0], v0[1]); w.y = cvt_pk_bf16(v0[2], v0[3]); w.z = cvt_pk_bf16(v1[0], v1[1]); w.w = cvt_pk_bf16(v1[2], v1[3]);
                    *(u32x4*)(rowp + bj * HALF) = w; } }
    }
};
template <bool BASE_BF, bool F32OUT>
struct EpiResidT {
    static constexpr bool PERM = BASE_BF, AFTER_DRAIN = false;
    const void* base; float* out; bf16_t* xb; float* part; int ldc;
    __device__ __forceinline__ void operator()(const f32x4 (&acc)[2][2][4][2], const Unit& u, int wr, int wc, int fr, int fq) const {
        typedef unsigned u32x2v __attribute__((ext_vector_type(2)));
        if constexpr (BASE_BF) {
            const int row0 = u.pm * BM + wr * 64 + fr; const int col0 = u.pn * BM + wc * 32 + 8 * fq;
            u32x4 bq[2][4][2];
#pragma unroll
            for (int ai = 0; ai < 2; ++ai)
#pragma unroll
                for (int m = 0; m < 4; ++m) { const size_t off = (size_t)(row0 + ai * HALF + m * 16) * ldc + col0;
#pragma unroll
                    for (int bj = 0; bj < 2; ++bj) bq[ai][m][bj] = *(const u32x4*)((const bf16_t*)base + off + bj * HALF); }
            float ssv[8];
#pragma unroll
            for (int ai = 0; ai < 2; ++ai)
#pragma unroll
                for (int m = 0; m < 4; ++m) { const int r = row0 + ai * HALF + m * 16; const size_t off = (size_t)r * ldc + col0; float ss = 0.f;
#pragma unroll
                    for (int bj = 0; bj < 2; ++bj) { const u32x4 q = bq[ai][m][bj];
                        const f32x4 b0 = {__uint_as_float(q.x << 16), __uint_as_float(q.x & 0xffff0000u), __uint_as_float(q.y << 16), __uint_as_float(q.y & 0xffff0000u)};
                        const f32x4 b1 = {__uint_as_float(q.z << 16), __uint_as_float(q.z & 0xffff0000u), __uint_as_float(q.w << 16), __uint_as_float(q.w & 0xffff0000u)};
                        const f32x4 o0 = b0 + acc[ai][bj][m][0], o1 = b1 + acc[ai][bj][m][1];
                        if (F32OUT) { *(f32x4*)(out + off + bj * HALF) = o0; *(f32x4*)(out + off + bj * HALF + 4) = o1; }
                        u32x4 w; w.x = cvt_pk_bf16(o0[0], o0[1]); w.y = cvt_pk_bf16(o0[2], o0[3]); w.z = cvt_pk_bf16(o1[0], o1[1]); w.w = cvt_pk_bf16(o1[2], o1[3]);
                        *(u32x4*)(xb + off + bj * HALF) = w;
                        ss += ((o0[0] * o0[0] + o0[1] * o0[1]) + (o0[2] * o0[2] + o0[3] * o0[3])) + ((o1[0] * o1[0] + o1[1] * o1[1]) + (o1[2] * o1[2] + o1[3] * o1[3])); }
                    ssv[ai * 4 + m] = ss; }
#pragma unroll
            for (int k = 0; k < 8; ++k) ssv[k] += __shfl_xor(ssv[k], 16);
#pragma unroll
            for (int k = 0; k < 8; ++k) ssv[k] += __shfl_xor(ssv[k], 32);
            if (fq == 0) {
#pragma unroll
                for (int k = 0; k < 8; ++k) part[(size_t)(row0 + (k >> 2) * HALF + (k & 3) * 16) * 32 + u.pn * 4 + wc] = ssv[k]; }
        } else {
        const int row0 = u.pm * BM + wr * 64 + fr; const int col0 = u.pn * BM + wc * 32 + 4 * fq;
#pragma unroll
        for (int ai = 0; ai < 2; ++ai)
#pragma unroll
            for (int m = 0; m < 4; ++m) { const int r = row0 + ai * HALF + m * 16; const size_t off = (size_t)r * ldc + col0; float ss = 0.f;
#pragma unroll
                for (int bj = 0; bj < 2; ++bj)
#pragma unroll
                    for (int n = 0; n < 2; ++n) { const f32x4 b = *(const f32x4*)((const float*)base + off + bj * HALF + n * 16);
                        const f32x4 o = b + acc[ai][bj][m][n];
                        if (F32OUT) *(f32x4*)(out + off + bj * HALF + n * 16) = o;
                        u32x2v w; w.x = cvt_pk_bf16(o[0], o[1]); w.y = cvt_pk_bf16(o[2], o[3]);
                        *(u32x2v*)(xb + off + bj * HALF + n * 16) = w; ss += (o[0] * o[0] + o[1] * o[1]) + (o[2] * o[2] + o[3] * o[3]); }
                ss += __shfl_xor(ss, 16); ss += __shfl_xor(ss, 32);
                if (fq == 0) part[(size_t)r * 32 + u.pn * 4 + wc] = ss;
                if (m & 1) asm volatile("" ::: "memory"); }
        }
    }
};
template <class Epi, class Sched, bool ALIGN_EPI = false, bool SP2 = false>
__device__ __forceinline__ void gemm_phase(PG8_LAS unsigned char* lds, const Gemm g, const Sched& S, const Epi& E) {
    int tid = threadIdx.x; asm volatile("" : "+v"(tid)); const int wid = __builtin_amdgcn_readfirstlane(tid >> 6), lane = tid & 63, wr = wid >> 2, wc = wid & 3, fr = lane & 15, fq = lane >> 4;
    const int K = g.K, nt = K / BK;
    unsigned voffA[2], voffB[2];
#pragma unroll
    for (int i = 0; i < 2; ++i) { int R, C; stage_rc(tid * 16 + i * 8192, R, C); const int Rb = Epi::PERM ? ((R & ~31) + perm32(R & 31)) : R;
        voffA[i] = (unsigned)(R * K + C) * 2u; voffB[i] = (unsigned)(Rb * K + C) * 2u; }
    const size_t kstep = (size_t)(BK * 2);
    const size_t hstep = (size_t)HALF * K * 2;
    const size_t tstep = 2 * hstep;
    const unsigned ldsw = (unsigned)wid * 1024u;
    const int aoff = lds_byte(wr * 64 + fr, fq * 8), boff = lds_byte(wc * 32 + fr, fq * 8);
#define PG8_SA(b, h) (((b) * 2 + (h)) * HTB)
#define PG8_SB(b, h) ((4 + (b) * 2 + (h)) * HTB)
#define PG8_STAGE(bufoff, gbase, voff) do { _Pragma("unroll") for (int _i = 0; _i < 2; ++_i) \
        __builtin_amdgcn_global_load_lds((const unsigned*)((const char*)(gbase) + (voff)[_i]), (PG8_LAS unsigned*)(lds + (bufoff) + ldsw + _i * 8192), 16, 0, 0); } while (0)
#define PG8_LDA(dst, b, h) do { _Pragma("unroll") for (int m = 0; m < 4; ++m) _Pragma("unroll") for (int k = 0; k < 2; ++k) dst[m][k] = *(const PG8_LAS bf16x8*)(lds + PG8_SA(b, h) + aoff + m * 2048 + k * 1024); } while (0)
#define PG8_LDB(dst, b, h) do { _Pragma("unroll") for (int n = 0; n < 2; ++n) _Pragma("unroll") for (int k = 0; k < 2; ++k) dst[n][k] = *(const PG8_LAS bf16x8*)(lds + PG8_SB(b, h) + boff + n * 2048 + k * 1024); } while (0)
#define PG8_MMA(ai, bj, At, Bt) do { __builtin_amdgcn_s_setprio(1); _Pragma("unroll") for (int m = 0; m < 4; ++m) _Pragma("unroll") for (int n = 0; n < 2; ++n) _Pragma("unroll") for (int k = 0; k < 2; ++k) \
        acc[ai][bj][m][n] = __builtin_amdgcn_mfma_f32_16x16x32_bf16(Bt[n][k], At[m][k], acc[ai][bj][m][n], 0, 0, 0); __builtin_amdgcn_s_setprio(0); } while (0)
#define PG8_WAIT_V(n) asm volatile("s_waitcnt vmcnt(" #n ")" ::: "memory")
#define PG8_WAIT_L(n) asm volatile("s_waitcnt lgkmcnt(" #n ")" ::: "memory")
#define PG8_BAR __builtin_amdgcn_s_barrier()
#define PG8_SCHED __builtin_amdgcn_sched_barrier(0)
    Unit cur, nxt; int ui = 0;
    if (!S.next(0, cur)) return;
    f32x4 acc[2][2][4][2];
#pragma unroll
    for (int a = 0; a < 2; ++a)
#pragma unroll
        for (int b = 0; b < 2; ++b)
#pragma unroll
            for (int m = 0; m < 4; ++m)
#pragma unroll
                for (int n = 0; n < 2; ++n) acc[a][b][m][n] = (f32x4){0.f, 0.f, 0.f, 0.f};
    bf16x8 At[4][2], B0[2][2], B1[2][2];
    const char* cA = (const char*)g.A + (size_t)cur.pm * tstep; const char* cB = (const char*)g.Bt + (size_t)cur.pn * tstep;
    S.a_ready(cur);
    if constexpr (SP2) {
        PG8_STAGE(PG8_SB(0, 0), cB, voffB); PG8_STAGE(PG8_SB(0, 1), cB + hstep, voffB); PG8_STAGE(PG8_SA(0, 0), cA, voffA); PG8_STAGE(PG8_SA(0, 1), cA + hstep, voffA);
        if (wr == 1) PG8_BAR;
        PG8_WAIT_V(2); PG8_BAR;
        PG8_STAGE(PG8_SB(1, 0), cB + kstep, voffB); PG8_STAGE(PG8_SA(1, 0), cA + kstep, voffA); PG8_STAGE(PG8_SB(1, 1), cB + hstep + kstep, voffB);
        PG8_WAIT_V(6); PG8_BAR;
    } else {
        PG8_STAGE(PG8_SB(0, 0), cB, voffB); PG8_STAGE(PG8_SA(0, 0), cA, voffA); PG8_STAGE(PG8_SB(0, 1), cB + hstep, voffB); PG8_STAGE(PG8_SA(0, 1), cA + hstep, voffA);
        if (wr == 1) PG8_BAR;
        PG8_WAIT_V(4); PG8_BAR;
        PG8_STAGE(PG8_SB(1, 0), cB + kstep, voffB); PG8_STAGE(PG8_SA(1, 0), cA + kstep, voffA); PG8_STAGE(PG8_SB(1, 1), cB + hstep + kstep, voffB);
        PG8_WAIT_V(6); PG8_BAR;
    }
    for (;;) {
        const bool has_next = S.next(ui + 1, nxt);
        const char* nA = has_next ? (const char*)g.A + (size_t)nxt.pm * tstep : cA; const char* nB = has_next ? (const char*)g.Bt + (size_t)nxt.pn * tstep : cB;
        for (int t = 0; t < nt; t += 2) {
            const bool last = (t == nt - 2);
            const char* a1 = cA + (size_t)(t + 1) * kstep;
            const char* a2 = last ? nA : cA + (size_t)(t + 2) * kstep; const char* b2 = last ? nB : cB + (size_t)(t + 2) * kstep;
            const char* a3 = a2 + kstep; const char* b3 = b2 + kstep;
            if (last && has_next) S.a_ready(nxt);
            if constexpr (SP2) {
            PG8_LDB(B0, 0, 0); PG8_LDB(B1, 0, 1); PG8_SCHED; PG8_LDA(At, 0, 0); PG8_STAGE(PG8_SA(1, 1), a1 + hstep, voffA);
            PG8_WAIT_V(8); PG8_WAIT_L(0); PG8_BAR; PG8_MMA(0, 0, At, B0); PG8_MMA(0, 1, At, B1); PG8_BAR; PG8_SCHED;
            PG8_LDA(At, 0, 1); PG8_STAGE(PG8_SB(0, 0), b2, voffB); PG8_STAGE(PG8_SB(0, 1), b2 + hstep, voffB); PG8_STAGE(PG8_SA(0, 0), a2, voffA);
            PG8_WAIT_V(8); PG8_WAIT_L(0); PG8_BAR; PG8_MMA(1, 0, At, B0); PG8_MMA(1, 1, At, B1); PG8_BAR; PG8_SCHED;
            PG8_LDB(B0, 1, 0); PG8_LDB(B1, 1, 1); PG8_SCHED; PG8_LDA(At, 1, 0); PG8_STAGE(PG8_SA(0, 1), a2 + hstep, voffA);
            PG8_WAIT_V(8); PG8_WAIT_L(0); PG8_BAR; PG8_MMA(0, 0, At, B0); PG8_MMA(0, 1, At, B1); PG8_BAR; PG8_SCHED;
            PG8_LDA(At, 1, 1); PG8_STAGE(PG8_SB(1, 0), b3, voffB); PG8_STAGE(PG8_SB(1, 1), b3 + hstep, voffB); PG8_STAGE(PG8_SA(1, 0), a3, voffA);
            PG8_WAIT_V(8); PG8_WAIT_L(0); PG8_BAR; PG8_MMA(1, 0, At, B0); PG8_MMA(1, 1, At, B1); PG8_BAR; PG8_SCHED;
            } else {
            PG8_LDB(B0, 0, 0); PG8_SCHED; PG8_LDA(At, 0, 0); PG8_STAGE(PG8_SA(1, 1), a1 + hstep, voffA);
            PG8_WAIT_L(8); PG8_BAR; PG8_WAIT_L(0); PG8_MMA(0, 0, At, B0); PG8_BAR; PG8_SCHED;
            PG8_LDB(B1, 0, 1); PG8_STAGE(PG8_SB(0, 0), b2, voffB);
            PG8_BAR; PG8_WAIT_L(0); PG8_MMA(0, 1, At, B1); PG8_BAR;
            PG8_LDA(At, 0, 1); PG8_STAGE(PG8_SA(0, 0), a2, voffA);
            PG8_BAR; PG8_WAIT_L(0); PG8_MMA(1, 0, At, B0); PG8_BAR; PG8_SCHED;
            PG8_STAGE(PG8_SB(0, 1), b2 + hstep, voffB);
            PG8_WAIT_V(6); PG8_BAR; PG8_MMA(1, 1, At, B1); PG8_BAR;
            PG8_LDB(B0, 1, 0); PG8_SCHED; PG8_LDA(At, 1, 0); PG8_STAGE(PG8_SA(0, 1), a2 + hstep, voffA);
            PG8_WAIT_L(8); PG8_BAR; PG8_WAIT_L(0); PG8_MMA(0, 0, At, B0); PG8_BAR; PG8_SCHED;
            PG8_LDB(B1, 1, 1); PG8_STAGE(PG8_SB(1, 0), b3, voffB);
            PG8_BAR; PG8_WAIT_L(0); PG8_MMA(0, 1, At, B1); PG8_BAR;
            PG8_LDA(At, 1, 1); PG8_STAGE(PG8_SA(1, 0), a3, voffA);
            PG8_BAR; PG8_WAIT_L(0); PG8_MMA(1, 0, At, B0); PG8_BAR; PG8_SCHED;
            PG8_STAGE(PG8_SB(1, 1), b3 + hstep, voffB);
            PG8_WAIT_V(6); PG8_BAR; PG8_MMA(1, 1, At, B1); PG8_BAR;
            }
        }
        if constexpr (ALIGN_EPI) { if (wr == 0) PG8_BAR; }
        if constexpr (!Epi::AFTER_DRAIN) { E(acc, cur, wr, wc, fr, fq); S.done(cur); }
        if (!has_next) break;
#pragma unroll
        for (int a = 0; a < 2; ++a)
#pragma unroll
            for (int b = 0; b < 2; ++b)
#pragma unroll
                for (int m = 0; m < 4; ++m)
#pragma unroll
                    for (int n = 0; n < 2; ++n) acc[a][b][m][n] = (f32x4){0.f, 0.f, 0.f, 0.f};
        cur = nxt; cA = nA; cB = nB; ++ui;
        if constexpr (ALIGN_EPI) { if (wr == 1) PG8_BAR; }
    }
    PG8_WAIT_V(0);
    if constexpr (!ALIGN_EPI) { if (wr == 0) PG8_BAR; }
    PG8_BAR;
    if constexpr (Epi::AFTER_DRAIN) { E.fused(acc, cur, wr, wc, fr, fq, lds, wid, lane); S.done(cur); }
#undef PG8_SA
#undef PG8_SB
#undef PG8_STAGE
#undef PG8_LDA
#undef PG8_LDB
#undef PG8_MMA
#undef PG8_WAIT_V
#undef PG8_WAIT_L
#undef PG8_BAR
#undef PG8_SCHED
}
}

#ifndef PG8_SP2
#define PG8_SP2 true
#endif
#ifndef PG8_ALIGN
#define PG8_ALIGN false
#endif
constexpr int NWAVES = 8, NTHREADS = 512;
constexpr int BATCH = 8, SEQ = 2048, DM = 2048, TOK = BATCH * SEQ;
constexpr float NORM_EPS = 1e-6f;
constexpr int MH = 4, MDK = 256, MDV = 512, MLSTM_IN = 6160, MPROJ = 6144;
constexpr int AHQ = 16, AHKV = 4, AD = 128, APROJ = 3072;
constexpr float PEER_U4_SCALE = 90.50966799f;
constexpr float PEER_U_SCALE = 2048.0f, PEER_V_SCALE = 128.0f, PEER_W_SCALE = 64.0f;
constexpr int PHEADS = 8, PKEYS = 128, PTOPK = 16, PHALF = 128, PEXP = 16384, PE = PHEADS * PTOPK;
constexpr size_t MiB = 1u << 20;
constexpr size_t WS_CTL = 0, CTL_ZERO_BYTES = 1 * MiB;
constexpr size_t WS_WIN  = 2 * MiB;
constexpr size_t WS_WOUT = 26 * MiB;
constexpr size_t WS_AIN  = 34 * MiB;
constexpr size_t WS_AOUT = 46 * MiB;
constexpr size_t WS_WQ   = 54 * MiB;
constexpr size_t WS_PK   = 70 * MiB;
constexpr size_t WS_ROPE = 71 * MiB;
constexpr size_t WS_GATE = 72 * MiB;
constexpr size_t WS_SC   = 73 * MiB;
constexpr size_t WS_RSTD = 75 * MiB;
constexpr size_t WS_PART = 76 * MiB;
constexpr size_t WS_IDX  = 78 * MiB;
constexpr size_t WS_GSM  = 86 * MiB;
constexpr size_t WS_XB0  = 96 * MiB;
constexpr size_t WS_XB1  = 160 * MiB;
constexpr size_t WS_XR   = 224 * MiB;
constexpr size_t WS_PROJ = 352 * MiB;
constexpr size_t WS_HS   = 544 * MiB;
constexpr size_t WS_HB   = 608 * MiB;
constexpr size_t WS_UB   = 672 * MiB;
constexpr size_t WS_VB   = 736 * MiB;
constexpr size_t WS_PSCR = 800 * MiB;
constexpr size_t WS_END  = 928 * MiB;
constexpr int CW_BAR = 4096, CW_RANK = 8192;
constexpr int RING_BYTES = 159744;
constexpr int LDSCTL_OFF = RING_BYTES, MISC_OFF = LDSCTL_OFF + 320;
constexpr int LDS_BYTES = 163840;
#define GAS __attribute__((address_space(1)))
#define LAS __attribute__((address_space(3)))
typedef unsigned short bf16;
typedef unsigned gu32;
typedef float f32x4 __attribute__((ext_vector_type(4)));
typedef float f32x2 __attribute__((ext_vector_type(2)));
typedef float f32x16 __attribute__((ext_vector_type(16)));
typedef unsigned u32x4 __attribute__((ext_vector_type(4)));
typedef unsigned u32x2 __attribute__((ext_vector_type(2)));
typedef short bf16x8 __attribute__((ext_vector_type(8)));
typedef short s16x4 __attribute__((ext_vector_type(4)));
#define RLX_AGENT __ATOMIC_RELAXED, __HIP_MEMORY_SCOPE_AGENT
#define LDS_WAIT() asm volatile("s_waitcnt lgkmcnt(0)" ::: "memory")
#define VM_WAIT() asm volatile("s_waitcnt vmcnt(0)" ::: "memory")
#define SBAR() __builtin_amdgcn_sched_barrier(0)
__device__ __forceinline__ unsigned cvtpk(float lo, float hi) { unsigned r; asm volatile("v_cvt_pk_bf16_f32 %0, %1, %2" : "=v"(r) : "v"(lo), "v"(hi)); return r; }
__device__ __forceinline__ float bf_lo(unsigned w) { return __uint_as_float(w << 16); }
__device__ __forceinline__ float bf_hi(unsigned w) { return __uint_as_float(w & 0xffff0000u); }
__device__ __forceinline__ int opaque_tid() { int t = threadIdx.x; asm volatile("" : "+v"(t)); return t; }
__device__ __forceinline__ void assume_global(const void* p) {
#if defined(__HIP_DEVICE_COMPILE__)
    __builtin_assume(!__builtin_amdgcn_is_shared((const __attribute__((address_space(0))) void*)p) && !__builtin_amdgcn_is_private((const __attribute__((address_space(0))) void*)p));
#endif
}
template <int CTRL> __device__ __forceinline__ float dpp_mov(float v) { return __builtin_bit_cast(float, __builtin_amdgcn_update_dpp(0, __builtin_bit_cast(int, v), CTRL, 0xf, 0xf, true)); }
__device__ __forceinline__ float row_sum16(float v) {
    v += dpp_mov<0xB1>(v);
    v += dpp_mov<0x4E>(v);
    v += dpp_mov<0x141>(v);
    v += dpp_mov<0x140>(v);
    return v;
}
__device__ __forceinline__ float wave_sum(float v) {
    v = row_sum16(v);
    const int iv = __builtin_bit_cast(int, v);
    return (__builtin_bit_cast(float, __builtin_amdgcn_readlane(iv, 0)) + __builtin_bit_cast(float, __builtin_amdgcn_readlane(iv, 16)))
         + (__builtin_bit_cast(float, __builtin_amdgcn_readlane(iv, 32)) + __builtin_bit_cast(float, __builtin_amdgcn_readlane(iv, 48)));
}
#define XB_TMO      128
#define XB_XCNT(j)  (256  + 64 * (j))
#define XB_XSUB(j)  (1280 + 64 * (j))
#define XB_XGEN(j)  (2304 + 64 * (j))
#define XB_TOP      3328
#define XB_TOPGEN   3392
#define XCD_BAR_WORDS 3456
#define XB_SPIN_CAP (1u << 20)
__device__ __forceinline__ unsigned xb_ld(unsigned* p)              { return __hip_atomic_load(p, __ATOMIC_RELAXED, __HIP_MEMORY_SCOPE_AGENT); }
__device__ __forceinline__ unsigned xb_add(unsigned* p, unsigned v) { return __hip_atomic_fetch_add(p, v, __ATOMIC_RELAXED, __HIP_MEMORY_SCOPE_AGENT); }
__device__ __forceinline__ unsigned xb_xcc_id() { return (unsigned)__builtin_amdgcn_s_getreg((3 << 11) | 20) & 0xFu; }
#define XB_SPIN(cond, bar) do { unsigned _sp = 0; while (cond) { __builtin_amdgcn_s_sleep(1); \
    if ((++_sp & 255u) == 0u) { if (xb_ld(&(bar)[XB_TMO])) break; if (_sp > XB_SPIN_CAP) { atomicAdd(&(bar)[XB_TMO], 1u); break; } } } } while (0)
struct XcdBarrier { unsigned* bar; unsigned x; volatile LAS unsigned* st; };
__device__ __forceinline__ XcdBarrier xcd_barrier_post(unsigned* bar, volatile LAS unsigned* st) {
    XcdBarrier b; b.bar = bar; b.x = xb_xcc_id(); b.st = st;
    if (threadIdx.x == 0) (void)xb_add(&bar[XB_XCNT(b.x)], 1u);
    return b;
}
__device__ __forceinline__ void xcd_barrier_complete(unsigned* bar, unsigned x, unsigned& nloc, unsigned& nx) {
    const unsigned G = gridDim.x * gridDim.y * gridDim.z;
    unsigned sum, cnt, mine, sp = 0u;
    for (;;) {
        sum = 0u; cnt = 0u; mine = 0u;
#pragma unroll
        for (unsigned j = 0; j < 16; ++j) { const unsigned c = xb_ld(&bar[XB_XCNT(j)]); sum += c; cnt += (c > 0u) ? 1u : 0u; mine = (j == x) ? c : mine; }
        if (sum == G) break;
        __builtin_amdgcn_s_sleep(1);
        if ((++sp & 255u) == 0u) { if (xb_ld(&bar[XB_TMO])) break; if (sp > XB_SPIN_CAP) { atomicAdd(&bar[XB_TMO], 1u); break; } }
    }
    nloc = mine > 0u ? mine : 1u; nx = cnt > 0u ? cnt : 1u;
}
__device__ __forceinline__ void xcd_barrier(const XcdBarrier& b) {
    asm volatile("s_waitcnt vmcnt(0)" ::: "memory");
    __syncthreads();
    if (threadIdx.x == 0) {
        unsigned* bar = b.bar;
        __builtin_amdgcn_s_waitcnt(0);
        unsigned nloc = b.st[0], nx = b.st[1];
        if (nloc == 0u) { xcd_barrier_complete(bar, b.x, nloc, nx); b.st[0] = nloc; b.st[1] = nx; }
        const unsigned old = xb_add(&bar[XB_XSUB(b.x)], 1u);
        const unsigned gen = old / nloc;
        if (old + 1u == (gen + 1u) * nloc) {
            __builtin_amdgcn_fence(__ATOMIC_RELEASE, "agent");
            asm volatile("s_waitcnt vmcnt(0)" ::: "memory");
            const unsigned og = xb_add(&bar[XB_TOP], 1u);
            const unsigned tg = og / nx;
            if (og + 1u == (tg + 1u) * nx) xb_add(&bar[XB_TOPGEN], 1u);
            else XB_SPIN(xb_ld(&bar[XB_TOPGEN]) == tg, bar);
            __builtin_amdgcn_fence(__ATOMIC_ACQUIRE, "agent");
            asm volatile("s_waitcnt vmcnt(0)" ::: "memory");
        } else {
            XB_SPIN(xb_ld(&bar[XB_TOPGEN]) == gen, bar);
            __builtin_amdgcn_fence(__ATOMIC_ACQUIRE, "agent");
            asm volatile("s_waitcnt vmcnt(0)" ::: "memory");
        }
    }
    __syncthreads();
}
struct Frame {
    LAS unsigned char* lds;
    volatile LAS unsigned* MISC;
    gu32* ctl;
    int tid, lane, wave, G;
    GAS unsigned char* ws;
    const GAS float* in[16];
    GAS float* out;
};
__device__ __forceinline__ unsigned f2bf(float f) { unsigned u = __builtin_bit_cast(unsigned, f); return (u + 0x7fffu + ((u >> 16) & 1u)) >> 16; }
__device__ __forceinline__ unsigned pk2(float lo, float hi) { return f2bf(lo) | (f2bf(hi) << 16); }
__device__ __forceinline__ void p0_transpose_item(const float* W, int ldw, int K, int ncols, bf16* WT, const float* gain, int qrows, LAS float* scr, int item, int lane) {
    const int nblk = ncols / 32, kb = item / nblk, nb = item % nblk, k0 = 64 * kb, n0 = 32 * nb;
    const float sc = (n0 < qrows) ? 0.0625f : 1.0f;
    const int c = lane & 7;
    float wv[32];
#pragma unroll
    for (int i = 0; i < 32; ++i) wv[i] = W[(size_t)(k0 + 2 * i + (lane >> 5)) * ldw + n0 + (lane & 31)];
    f32x4 ga = {sc, sc, sc, sc}, gb = ga;
    if (gain) { ga = *(const f32x4*)(gain + k0 + 8 * c) * sc; gb = *(const f32x4*)(gain + k0 + 8 * c + 4) * sc; }
#pragma unroll
    for (int i = 0; i < 32; ++i) { const int kk = 2 * i + (lane >> 5); scr[kk * 33 + (lane & 31)] = wv[i]; }
    LDS_WAIT(); asm volatile("" ::: "memory");
#pragma unroll
    for (int j = 0; j < 4; ++j) { const int n = (lane >> 3) + 8 * j; const LAS float* s = scr + (8 * c) * 33 + n;
        u32x4 o; o.x = pk2(s[0 * 33] * ga[0], s[1 * 33] * ga[1]); o.y = pk2(s[2 * 33] * ga[2], s[3 * 33] * ga[3]); o.z = pk2(s[4 * 33] * gb[0], s[5 * 33] * gb[1]); o.w = pk2(s[6 * 33] * gb[2], s[7 * 33] * gb[3]);
        *(u32x4*)(WT + (size_t)(n0 + n) * K + k0 + 8 * c) = o; }
    LDS_WAIT(); asm volatile("" ::: "memory");
}
__device__ __forceinline__ void p0_convert(const float* src, bf16* dst, size_t n8, const float* gain, size_t gtid, size_t gthreads) {
    for (size_t i = gtid; i < n8; i += gthreads) {
        const f32x4 a = *(const f32x4*)(src + i * 8), b = *(const f32x4*)(src + i * 8 + 4);
        f32x4 ga = {1.f, 1.f, 1.f, 1.f}, gb = ga;
        if (gain) { const int c = (int)((i * 8) & 2047); ga = *(const f32x4*)(gain + c); gb = *(const f32x4*)(gain + c + 4); }
        u32x4 o; o.x = cvtpk(a[0] * ga[0], a[1] * ga[1]); o.y = cvtpk(a[2] * ga[2], a[3] * ga[3]); o.z = cvtpk(b[0] * gb[0], b[1] * gb[1]); o.w = cvtpk(b[2] * gb[2], b[3] * gb[3]);
        *(u32x4*)(dst + i * 8) = o;
    }
}
__device__ __forceinline__ void p0_convert_sliced_fp4(const float* src, unsigned char* dst, const float* gain, float scale, size_t gtid, size_t gthreads) {
    const size_t n32 = (size_t)PEXP * DM / 32;
#pragma unroll 2
    for (size_t i = gtid; i < n32; i += gthreads) {
        const int c32 = (int)(i & 63); const size_t e = i >> 6;
        u32x4 o;
#pragma unroll
        for (int q = 0; q < 4; ++q) {
            f32x4 a0 = *(const f32x4*)(src + i * 32 + q * 8), a1 = *(const f32x4*)(src + i * 32 + q * 8 + 4);
            if (gain) { a0 = a0 * *(const f32x4*)(gain + c32 * 32 + q * 8); a1 = a1 * *(const f32x4*)(gain + c32 * 32 + q * 8 + 4); }
            a0 = a0 * scale; a1 = a1 * scale;
#pragma unroll
            for (int k = 0; k < 4; ++k) { a0[k] = __builtin_amdgcn_fmed3f(a0[k], -6.f, 6.f); a1[k] = __builtin_amdgcn_fmed3f(a1[k], -6.f, 6.f); }
            unsigned p4 = 0;
            p4 = __builtin_amdgcn_cvt_scalef32_pk_fp4_f32(p4, a0[0], a0[1], 1.0f, 0); p4 = __builtin_amdgcn_cvt_scalef32_pk_fp4_f32(p4, a0[2], a0[3], 1.0f, 1);
            p4 = __builtin_amdgcn_cvt_scalef32_pk_fp4_f32(p4, a1[0], a1[1], 1.0f, 2); p4 = __builtin_amdgcn_cvt_scalef32_pk_fp4_f32(p4, a1[2], a1[3], 1.0f, 3);
            o[q] = p4;
        }
        *(u32x4*)(dst + (((size_t)(c32 >> 3) * PEXP + e) * 8 + (c32 & 7)) * 16) = o;
    }
}
__device__ __forceinline__ void p0_convert_rows_fp4g(const float* src, unsigned char* dst, const float* gain, float scale, int gw, int ngw, int lane) {
    f32x4 gs[8];
#pragma unroll
    for (int q = 0; q < 8; ++q) gs[q] = *(const f32x4*)(gain + q * 256 + 4 * lane) * scale;
#pragma unroll 2
    for (int e = gw; e < PEXP; e += ngw) {
        f32x4 a[8];
#pragma unroll
        for (int q = 0; q < 8; ++q) a[q] = *(const f32x4*)(src + (size_t)e * DM + q * 256 + 4 * lane);
#pragma unroll
        for (int q = 0; q < 8; ++q) {
            const f32x4 v = a[q] * gs[q];
            const unsigned p4 = __builtin_amdgcn_cvt_scalef32_pk_fp4_f32(__builtin_amdgcn_cvt_scalef32_pk_fp4_f32(0u, __builtin_amdgcn_fmed3f(v[0], -6.f, 6.f), __builtin_amdgcn_fmed3f(v[1], -6.f, 6.f), 1.0f, 0),
                                                                           __builtin_amdgcn_fmed3f(v[2], -6.f, 6.f), __builtin_amdgcn_fmed3f(v[3], -6.f, 6.f), 1.0f, 1);
            *(unsigned short*)(dst + ((size_t)q * PEXP + e) * 128 + 2 * lane) = (unsigned short)p4;
        }
    }
}
__device__ __forceinline__ void p0_convert_sliced_fp4v(const float* src, unsigned char* dst, float scale, size_t gtid, size_t gthreads) {
    const size_t n64 = (size_t)PEXP * DM / 64;
#pragma unroll 1
    for (size_t i = gtid; i < n64; i += gthreads) {
        const int w64 = (int)(i & 31); const size_t e = i >> 5;
        f32x4 a[16];
#pragma unroll
        for (int n = 0; n < 16; ++n) { a[n] = *(const f32x4*)(src + i * 64 + n * 4) * scale;
#pragma unroll
            for (int k = 0; k < 4; ++k) a[n][k] = __builtin_amdgcn_fmed3f(a[n][k], -6.f, 6.f); }
        u32x4 o0, o1;
#pragma unroll
        for (int d = 0; d < 4; ++d) {
            const int k = d >> 1, nb = 8 * (d & 1);
            unsigned p0 = 0, p1 = 0;
            p0 = __builtin_amdgcn_cvt_scalef32_pk_fp4_f32(p0, a[nb + 0][k], a[nb + 1][k], 1.0f, 0); p0 = __builtin_amdgcn_cvt_scalef32_pk_fp4_f32(p0, a[nb + 2][k], a[nb + 3][k], 1.0f, 1);
            p0 = __builtin_amdgcn_cvt_scalef32_pk_fp4_f32(p0, a[nb + 4][k], a[nb + 5][k], 1.0f, 2); p0 = __builtin_amdgcn_cvt_scalef32_pk_fp4_f32(p0, a[nb + 6][k], a[nb + 7][k], 1.0f, 3);
            p1 = __builtin_amdgcn_cvt_scalef32_pk_fp4_f32(p1, a[nb + 0][k + 2], a[nb + 1][k + 2], 1.0f, 0); p1 = __builtin_amdgcn_cvt_scalef32_pk_fp4_f32(p1, a[nb + 2][k + 2], a[nb + 3][k + 2], 1.0f, 1);
            p1 = __builtin_amdgcn_cvt_scalef32_pk_fp4_f32(p1, a[nb + 4][k + 2], a[nb + 5][k + 2], 1.0f, 2); p1 = __builtin_amdgcn_cvt_scalef32_pk_fp4_f32(p1, a[nb + 6][k + 2], a[nb + 7][k + 2], 1.0f, 3);
            o0[d] = p0; o1[d] = p1;
        }
        unsigned char* piece = dst + ((size_t)(w64 >> 2) * PEXP + e) * 128;
        *(u32x4*)(piece + (w64 & 3) * 16) = o0; *(u32x4*)(piece + ((w64 & 3) + 4) * 16) = o1;
    }
}
__device__ __forceinline__ void p0_convert_rows_fp4v(const float* src, unsigned char* dst, float scale, int gw, int ngw, int lane) {
    const int n = lane & 15, r = lane >> 4; const bool odd = (n & 1) != 0;
    const int boff = (n >> 1) + 8 * (n & 1);
    for (int blk = gw; blk < PEXP / 4 * 4; blk += ngw) {
        const int e = (blk >> 2) * 4 + r, w0 = (blk & 3) * 8;
        f32x4 a[8];
#pragma unroll
        for (int q = 0; q < 8; ++q) a[q] = *(const f32x4*)(src + (size_t)e * DM + (w0 + q) * 64 + 4 * n);
#pragma unroll
        for (int q = 0; q < 8; ++q) {
            f32x4 v = a[q] * scale, p;
#pragma unroll
            for (int k = 0; k < 4; ++k) { v[k] = __builtin_amdgcn_fmed3f(v[k], -6.f, 6.f); p[k] = dpp_mov<0xB1>(v[k]); }
            const unsigned b0 = __builtin_amdgcn_cvt_scalef32_pk_fp4_f32(0u, odd ? p[1] : v[0], odd ? v[1] : p[0], 1.0f, 0) & 0xffu;
            const unsigned b1 = __builtin_amdgcn_cvt_scalef32_pk_fp4_f32(0u, odd ? p[3] : v[2], odd ? v[3] : p[2], 1.0f, 0) & 0xffu;
            const int w64 = w0 + q;
            unsigned char* piece = dst + ((size_t)(w64 >> 2) * PEXP + e) * 128 + (w64 & 3) * 16 + boff;
            piece[0] = (unsigned char)b0; piece[64] = (unsigned char)b1;
        }
    }
}
#ifdef P0_U_OLD
#define P0_CONV_U(l) p0_convert_sliced_fp4(pu + (size_t)(l) * PEXP * DM, (unsigned char*)(ws + WS_UB) + (size_t)(l) * PEXP * (DM / 2), ln_ffn + (l) * DM, PEER_U4_SCALE, gtid, gthreads)
#else
#define P0_CONV_U(l) p0_convert_rows_fp4g(pu + (size_t)(l) * PEXP * DM, (unsigned char*)(ws + WS_UB) + (size_t)(l) * PEXP * (DM / 2), ln_ffn + (l) * DM, PEER_U4_SCALE, gw, NGW, F.lane)
#endif
__device__ __forceinline__ void p0_prologue(Frame& F) {
    const float* x = (const float*)F.in[0]; const float* ln_mix = (const float*)F.in[1]; const float* ln_ffn = (const float*)F.in[2]; const float* w_in = (const float*)F.in[3]; const float* gate_bias = (const float*)F.in[4];
    const float* w_out = (const float*)F.in[6]; const float* a_in = (const float*)F.in[7]; const float* a_out = (const float*)F.in[10]; const float* wq = (const float*)F.in[11];
    const float* k1 = (const float*)F.in[12]; const float* k2 = (const float*)F.in[13]; const float* pu = (const float*)F.in[14]; const float* pv = (const float*)F.in[15];
    GAS unsigned char* ws = F.ws;
    const int gw = blockIdx.x * NWAVES + F.wave, NGW = F.G * NWAVES;
    const size_t gtid = (size_t)blockIdx.x * NTHREADS + F.tid, gthreads = (size_t)F.G * NTHREADS;
#ifndef REP_P0
#define REP_P0 0
#endif
    for (int rp_ = 0; rp_ < 1 + (REP_P0 & 1); ++rp_) {
        LAS float* scr = (LAS float*)(F.lds + F.wave * 16384);
        constexpr int I_IN = (DM / 64) * (MPROJ / 32), I_SQ = (DM / 64) * (DM / 32), I_AIN = (DM / 64) * (APROJ / 32);
        constexpr int NITEMS = I_IN + I_SQ + I_AIN + I_SQ + 2 * I_SQ;
        for (int it = gw; it < NITEMS; it += NGW) {
            int r = it;
            if (r < I_IN) { p0_transpose_item(w_in, MLSTM_IN, DM, MPROJ, (bf16*)(ws + WS_WIN), ln_mix, 1024, scr, r, F.lane); continue; } r -= I_IN;
            if (r < I_SQ) { p0_transpose_item(w_out, DM, DM, DM, (bf16*)(ws + WS_WOUT), nullptr, 0, scr, r, F.lane); continue; } r -= I_SQ;
            if (r < I_AIN) { p0_transpose_item(a_in, APROJ, DM, APROJ, (bf16*)(ws + WS_AIN), ln_mix + DM, 0, scr, r, F.lane); continue; } r -= I_AIN;
            if (r < I_SQ) { p0_transpose_item(a_out, DM, DM, DM, (bf16*)(ws + WS_AOUT), nullptr, 0, scr, r, F.lane); continue; } r -= I_SQ;
            if (r < I_SQ) { p0_transpose_item(wq, DM, DM, DM, (bf16*)(ws + WS_WQ), ln_ffn, 0, scr, r, F.lane); continue; } r -= I_SQ;
            p0_transpose_item(wq + (size_t)DM * DM, DM, DM, DM, (bf16*)(ws + WS_WQ) + (size_t)DM * DM, ln_ffn + DM, 0, scr, r, F.lane);
        }
    }
    for (int rp_ = 0; rp_ < 1 + ((REP_P0 >> 1) & 1); ++rp_) {
        for (int l = 0; l < 2; ++l) {
#ifdef P0_REP_NOU
            if (rp_ == 0)
#endif
            P0_CONV_U(l);
#ifdef P0_REP_NOV
            if (rp_ == 0)
#endif
            p0_convert_rows_fp4v(pv + (size_t)l * PEXP * DM, (unsigned char*)(ws + WS_VB) + (size_t)l * PEXP * (DM / 2), 5.656854249f, gw, NGW, F.lane);
            p0_convert(k1 + (size_t)l * PKEYS * PHALF, (bf16*)(ws + WS_PK) + (size_t)(l * 2 + 0) * PKEYS * PHALF, (size_t)PKEYS * PHALF / 8, nullptr, gtid, gthreads);
            p0_convert(k2 + (size_t)l * PKEYS * PHALF, (bf16*)(ws + WS_PK) + (size_t)(l * 2 + 1) * PKEYS * PHALF, (size_t)PKEYS * PHALF / 8, nullptr, gtid, gthreads);
        }
        float* cosT = (float*)(ws + WS_ROPE); float* sinT = cosT + SEQ * 64;
        for (size_t i = gtid; i < (size_t)SEQ * 64; i += gthreads) {
            const int t = (int)(i >> 6), j = (int)(i & 63);
            const float freq = powf(10000.0f, -(float)(j & 31) / 32.0f);
            const float pos = (j < 32) ? (float)(t >> 6) : (float)(t & 63);
            const float ang = pos * freq;
            cosT[i] = cosf(ang); sinT[i] = sinf(ang);
        }
    }
    __syncthreads();
    for (int rp_ = 0; rp_ < 1 + ((REP_P0 >> 2) & 1); ++rp_) {
        __syncthreads();
        LAS float* Wg = (LAS float*)F.lds;
        for (int i = F.tid; i < 16 * DM; i += NTHREADS) { const int k = i >> 4, g = i & 15; Wg[g * DM + k] = w_in[(size_t)k * MLSTM_IN + MPROJ + g] * ln_mix[k]; }
        __syncthreads();
        float* rstd0 = (float*)(ws + WS_RSTD); float* gates = (float*)(ws + WS_GATE); bf16* xb = (bf16*)(ws + WS_XB0);
        f32x4 vn[8];
        if (gw < TOK) { const f32x4* xr0 = (const f32x4*)(x + (size_t)gw * DM) + F.lane;
#pragma unroll
            for (int j = 0; j < 8; ++j) vn[j] = xr0[64 * j]; }
        for (int m = gw; m < TOK; m += NGW) {
            f32x4 v[8]; float ss = 0.f;
#pragma unroll
            for (int j = 0; j < 8; ++j) { v[j] = vn[j]; ss += (v[j][0] * v[j][0] + v[j][1] * v[j][1]) + (v[j][2] * v[j][2] + v[j][3] * v[j][3]); }
            { const int mn = (m + NGW < TOK) ? m + NGW : m; const f32x4* xrn = (const f32x4*)(x + (size_t)mn * DM) + F.lane;
#pragma unroll
              for (int j = 0; j < 8; ++j) vn[j] = xrn[64 * j]; }
            const float rstd = 1.0f / sqrtf(wave_sum(ss) * (1.0f / DM) + NORM_EPS);
            u32x2* o8 = (u32x2*)(xb + (size_t)m * DM) + F.lane;
#pragma unroll
            for (int j = 0; j < 8; ++j) { u32x2 w; w.x = cvtpk(v[j][0], v[j][1]); w.y = cvtpk(v[j][2], v[j][3]); o8[64 * j] = w; }
            float mine = 0.f;
#pragma unroll
            for (int g = 0; g < 16; ++g) {
                float s = 0.f;
#pragma unroll
                for (int j = 0; j < 8; ++j) { const f32x4 w = *(const LAS f32x4*)(Wg + g * DM + 256 * j + 4 * F.lane); s += (v[j][0] * w[0] + v[j][1] * w[1]) + (v[j][2] * w[2] + v[j][3] * w[3]); }
                s = wave_sum(s);
                if (F.lane == g) mine = s;
            }
            if (F.lane < 16) gates[(size_t)m * 16 + F.lane] = mine * rstd + gate_bias[F.lane];
            if (F.lane == 0) rstd0[m] = rstd;
        }
    }
    __syncthreads();
}
__device__ __forceinline__ int crow(int r, int hi) { return (r & 3) + 8 * (r >> 2) + 4 * hi; }
template <int ND0, int ROWB>
__device__ __forceinline__ void qkt(f32x16& p0, f32x16& p1, const char* Ks, const bf16x8* qr, int r32, int hi) {
    p0 = f32x16{}; p1 = f32x16{};
    int sw = (r32 & 7) << 4;
    asm volatile("" : "+v"(sw));
#pragma unroll
    for (int d0 = 0; d0 < ND0; ++d0) { const int cb = (d0 * 16 + hi * 8) * 2;
        const bf16x8 b0 = *reinterpret_cast<const bf16x8*>(Ks + r32 * ROWB + (cb ^ sw));
        const bf16x8 b1 = *reinterpret_cast<const bf16x8*>(Ks + (32 + r32) * ROWB + (cb ^ sw));
        p0 = __builtin_amdgcn_mfma_f32_32x32x16_bf16(b0, qr[d0], p0, 0, 0, 0);
        p1 = __builtin_amdgcn_mfma_f32_32x32x16_bf16(b1, qr[d0], p1, 0, 0, 0); }
}
__device__ __forceinline__ int v_st(int k, int c) { const int kk = (k & ~0xC) | ((k & 4) << 1) | ((k & 8) >> 1); return ((kk >> 3) * 4 + (c >> 5)) * 512 + ((kk & 7) * 32 + (c & 31)) * 2; }
__device__ __forceinline__ int v_rd_base(int lane) { return ((lane & 3) << 3) | (((lane >> 2) & 3) << 6) | (((lane >> 4) & 1) << 5) | (((lane >> 5) & 1) << 8); }
constexpr int v_rd_off(int d0, int ks, int half) { return d0 * 512 + ks * 4096 + half * 2048; }
template <int OFF> __device__ __forceinline__ s16x4 tr_read(int vb) {
    s16x4 r; asm volatile("ds_read_b64_tr_b16 %0, %1 offset:%2" : "=&v"(r) : "v"(vb), "i"(OFF) : "memory"); return r;
}
template <int D0> __device__ __forceinline__ void pv_one(f32x16& od, int vb, bf16x8 pa0, bf16x8 pa1, bf16x8 pa2, bf16x8 pa3) {
    const s16x4 l0 = tr_read<v_rd_off(D0, 0, 0)>(vb), h0 = tr_read<v_rd_off(D0, 0, 1)>(vb), l1 = tr_read<v_rd_off(D0, 1, 0)>(vb), h1 = tr_read<v_rd_off(D0, 1, 1)>(vb);
    const s16x4 l2 = tr_read<v_rd_off(D0, 2, 0)>(vb), h2 = tr_read<v_rd_off(D0, 2, 1)>(vb), l3 = tr_read<v_rd_off(D0, 3, 0)>(vb), h3 = tr_read<v_rd_off(D0, 3, 1)>(vb);
    asm volatile("s_waitcnt lgkmcnt(0)" ::: "memory"); SBAR();
#define PKV(L, H) (bf16x8){L[0], L[1], L[2], L[3], H[0], H[1], H[2], H[3]}
    od = __builtin_amdgcn_mfma_f32_32x32x16_bf16(pa0, PKV(l0, h0), od, 0, 0, 0);
    od = __builtin_amdgcn_mfma_f32_32x32x16_bf16(pa1, PKV(l1, h1), od, 0, 0, 0);
    od = __builtin_amdgcn_mfma_f32_32x32x16_bf16(pa2, PKV(l2, h2), od, 0, 0, 0);
    od = __builtin_amdgcn_mfma_f32_32x32x16_bf16(pa3, PKV(l3, h3), od, 0, 0, 0);
#undef PKV
}
__device__ __forceinline__ void pv_d0(f32x16* o, int vb, bf16x8 pa0, bf16x8 pa1, bf16x8 pa2, bf16x8 pa3) {
    pv_one<0>(o[0], vb, pa0, pa1, pa2, pa3); pv_one<1>(o[1], vb, pa0, pa1, pa2, pa3); pv_one<2>(o[2], vb, pa0, pa1, pa2, pa3); pv_one<3>(o[3], vb, pa0, pa1, pa2, pa3);
}
#define PK4(P, BASE, OUT) do { unsigned a0_ = cvtpk(P[BASE + 0], P[BASE + 1]), a1_ = cvtpk(P[BASE + 2], P[BASE + 3]);   \
    unsigned b0_ = cvtpk(P[BASE + 4], P[BASE + 5]), b1_ = cvtpk(P[BASE + 6], P[BASE + 7]);                              \
    auto r0_ = __builtin_amdgcn_permlane32_swap(a0_, b0_, false, false); auto r1_ = __builtin_amdgcn_permlane32_swap(a1_, b1_, false, false); \
    u32x4 w_ = {r0_[0], r1_[0], r0_[1], r1_[1]}; OUT = *reinterpret_cast<bf16x8*>(&w_); } while (0)

namespace ml {
constexpr int LD = MPROJ;
constexpr int SHM_V = 64 * 128 * 2, SHM_K = 64 * 256 * 2;
constexpr int OFF_V = 0, OFF_K = 2 * SHM_V, OFF_WS = OFF_K + 2 * SHM_K, OFF_G = OFF_WS + NWAVES * 256, LDS_END = OFF_G + 2 * SEQ * 4;
static_assert(LDS_END <= RING_BYTES, "mlstm LDS");
constexpr float LOG2E = 1.4426950408889634f;

__device__ __forceinline__ void scan(Frame& F, int bh, int dir) {
    const int b = bh >> 2, h = bh & 3;
    const float* gates = (const float*)(F.ws + WS_GATE);
    float* SC = (float*)(F.ws + WS_SC) + (size_t)bh * 6 * SEQ;
    LAS float* red = (LAS float*)F.lds;
    {
        float ig[4], s[4]; int tt[4];
#pragma unroll
        for (int j = 0; j < 4; ++j) { const int p = F.tid * 4 + j, t = dir ? (SEQ - 1 - p) : p; tt[j] = t;
            const float* gr = gates + (size_t)(b * SEQ + t) * 16; ig[j] = gr[dir * 8 + h]; const float fg = gr[dir * 8 + 4 + h];
            s[j] = fminf(fg, 0.f) - log1pf(expf(-fabsf(fg))); }
        s[1] += s[0]; s[2] += s[1]; s[3] += s[2];
        const float tot = s[3]; float inc = tot;
#pragma unroll
        for (int o = 1; o < 64; o <<= 1) { const float n = __shfl_up(inc, o); if (F.lane >= o) inc += n; }
        if (F.lane == 63) red[F.wave] = inc;
        __syncthreads();
        float woff = 0.f;
        for (int w = 0; w < F.wave; ++w) woff += red[w];
        const float excl = woff + inc - tot;
        float Bv[4], g[4], pm[4];
#pragma unroll
        for (int j = 0; j < 4; ++j) { Bv[j] = excl + s[j]; g[j] = ig[j] - Bv[j]; }
        pm[0] = g[0]; pm[1] = fmaxf(pm[0], g[1]); pm[2] = fmaxf(pm[1], g[2]); pm[3] = fmaxf(pm[2], g[3]);
        float minc = pm[3];
#pragma unroll
        for (int o = 1; o < 64; o <<= 1) { const float n = __shfl_up(minc, o); if (F.lane >= o) minc = fmaxf(minc, n); }
        if (F.lane == 63) red[16 + F.wave] = minc;
        __syncthreads();
        float wmax = -3.0e38f;
        for (int w = 0; w < F.wave; ++w) wmax = fmaxf(wmax, red[16 + w]);
        const float prev = __shfl_up(minc, 1);
        const float exm = (F.lane > 0) ? fmaxf(wmax, prev) : wmax;
#pragma unroll
        for (int j = 0; j < 4; ++j) { const float c = fmaxf(0.f, fmaxf(exm, pm[j])); const float m = Bv[j] + c;
            SC[(dir * 3 + 0) * SEQ + tt[j]] = g[j] * LOG2E; SC[(dir * 3 + 1) * SEQ + tt[j]] = c * LOG2E; SC[(dir * 3 + 2) * SEQ + tt[j]] = expf(-m); }
        __syncthreads();
    }
}

}
namespace ml2 {
constexpr int LD = MPROJ;
constexpr int KT = 32;
constexpr int SHM_K = KT * 512, SHM_V = KT * 1024;
constexpr int NBUF = 3;
constexpr int OFF_K = 0, OFF_V = NBUF * SHM_K, OFF_WS = OFF_V + NBUF * SHM_V, OFF_G = OFF_WS + NWAVES * 256, LDS_END = OFF_G + SEQ * 4;
static_assert(LDS_END <= RING_BYTES, "mlstm16 LDS");

template <int DIR, int VAR = 0>
__device__ __forceinline__ void pass(const bf16* Qb, const bf16* Kh, const bf16* Vh, bf16* Hb, const float* C2g, const float* ECg, int r0u, char* lds) {
    const int tid = opaque_tid(), wid = tid >> 6, lane = tid & 63, n16 = lane & 15, g = lane >> 4, q4 = n16 >> 2, p4 = lane & 3;
    const int wu = __builtin_amdgcn_readfirstlane(wid);
    char* K_lds = lds + OFF_K; char* V_lds = lds + OFF_V;
    const float* Gf = (const float*)(lds + OFF_G);
    float* li_l = (float*)(lds + OFF_WS) + wid * 64; float* ec_l = li_l + 32;
    const int rlo = r0u + wid * 16, rhi = rlo + 15, trow = rlo + n16;
    bf16x8 qr[8];
    { const bf16* Qw = Qb + (size_t)(wid * 16 + n16) * LD + 8 * g;
#pragma unroll
      for (int s = 0; s < 8; ++s) qr[s] = *reinterpret_cast<const bf16x8*>(Qw + 32 * s); }
    const float c2 = C2g[trow], ec = ECg[trow];
    f32x4 o[32];
#pragma unroll
    for (int i = 0; i < 32; ++i) o[i] = (f32x4){0.f, 0.f, 0.f, 0.f};
    float den = 0.f;
    const int j0 = DIR == 0 ? 0 : (r0u >> 5), n = DIR == 0 ? (r0u >> 5) + 4 : 64 - (r0u >> 5);
    unsigned koff[2], voff[4];
#pragma unroll
    for (int i_ = 0; i_ < 2; ++i_) { const int row_ = 2 * (wid * 2 + i_) + (lane >> 5), kc_ = (lane & 31) ^ (row_ & 15); koff[i_] = (unsigned)(row_ * LD + kc_ * 8); }
#pragma unroll
    for (int i_ = 0; i_ < 4; ++i_) { const int pc = wid * 4 + i_, sl = pc >> 3, oo = (pc >> 1) & 3, cb = 4 * (pc & 1) + (lane >> 4), kq = (lane >> 1) & 7;
        voff[i_] = (unsigned)((8 * oo + kq) * LD + sl * 128 + 16 * cb + 8 * (lane & 1)); }
#define M2_STAGE(b, k0) do { _Pragma("unroll") for (int i_ = 0; i_ < 2; ++i_) \
        __builtin_amdgcn_global_load_lds((const unsigned*)(Kh + (size_t)(k0) * LD + koff[i_]), (LAS unsigned*)(uintptr_t)(unsigned)((unsigned)(uintptr_t)K_lds + (b) * SHM_K + (wu * 2 + i_) * 1024), 16, 0, 0); \
        _Pragma("unroll") for (int i_ = 0; i_ < 4; ++i_) \
        __builtin_amdgcn_global_load_lds((const unsigned*)(Vh + (size_t)(k0) * LD + voff[i_]), (LAS unsigned*)(uintptr_t)(unsigned)((unsigned)(uintptr_t)V_lds + (b) * SHM_V + (wu * 4 + i_) * 1024), 16, 0, 0); } while (0)
    int ksw = n16 << 4; asm volatile("" : "+v"(ksw));
    const int trb = (int)(uintptr_t)V_lds + (g >> 1) * 2048 + (4 * (g & 1) + q4) * 32 + p4 * 8;
#define M2_RD(cb, sl, L, H) L = tr_read<(sl) * 8192 + (cb) * 256>(trv); H = tr_read<(sl) * 8192 + (cb) * 256 + 4096>(trv)
#define M2_MM(cb, sl, L, H) o[(sl) * 8 + (cb)] = __builtin_amdgcn_mfma_f32_16x16x32_bf16(pa, (bf16x8){L[0], L[1], L[2], L[3], H[0], H[1], H[2], H[3]}, o[(sl) * 8 + (cb)], 0, 0, 0)
#define M2_RD4(q, L, H) do { M2_RD(4 * ((q) & 1) + 0, (q) >> 1, L##0, H##0); M2_RD(4 * ((q) & 1) + 1, (q) >> 1, L##1, H##1); M2_RD(4 * ((q) & 1) + 2, (q) >> 1, L##2, H##2); M2_RD(4 * ((q) & 1) + 3, (q) >> 1, L##3, H##3); } while (0)
#define M2_MM4(q, L, H) do { M2_MM(4 * ((q) & 1) + 0, (q) >> 1, L##0, H##0); M2_MM(4 * ((q) & 1) + 1, (q) >> 1, L##1, H##1); M2_MM(4 * ((q) & 1) + 2, (q) >> 1, L##2, H##2); M2_MM(4 * ((q) & 1) + 3, (q) >> 1, L##3, H##3); } while (0)
#define M2_WAIT8() do { asm volatile("s_waitcnt lgkmcnt(8)" ::: "memory"); SBAR(); } while (0)
#define M2_WAIT0() do { asm volatile("s_waitcnt lgkmcnt(0)" ::: "memory"); SBAR(); } while (0)
#define M2_PV() do { s16x4 xa0, xa1, xa2, xa3, ya0, ya1, ya2, ya3, xb0, xb1, xb2, xb3, yb0, yb1, yb2, yb3; \
        M2_RD4(0, xa, ya); \
        M2_RD4(1, xb, yb); M2_WAIT8(); M2_MM4(0, xa, ya); \
        M2_RD4(2, xa, ya); M2_WAIT8(); M2_MM4(1, xb, yb); \
        M2_RD4(3, xb, yb); M2_WAIT8(); M2_MM4(2, xa, ya); \
        M2_RD4(4, xa, ya); M2_WAIT8(); M2_MM4(3, xb, yb); \
        M2_RD4(5, xb, yb); M2_WAIT8(); M2_MM4(4, xa, ya); \
        M2_RD4(6, xa, ya); M2_WAIT8(); M2_MM4(5, xb, yb); \
        M2_RD4(7, xb, yb); M2_WAIT8(); M2_MM4(6, xa, ya); \
        M2_WAIT0(); M2_MM4(7, xb, yb); } while (0)
    { float* Gl = (float*)(lds + OFF_G); const float* Gs = C2g - SEQ;
      static_assert(SEQ == 4 * NTHREADS, "G copy");
      float gv_[4];
#pragma unroll
      for (int u_ = 0; u_ < 4; ++u_) gv_[u_] = Gs[tid + u_ * NTHREADS];
#pragma unroll
      for (int u_ = 0; u_ < 4; ++u_) Gl[tid + u_ * NTHREADS] = gv_[u_]; }
    M2_STAGE(0, j0 * KT); M2_STAGE(1, (j0 + 1) * KT);
    asm volatile("s_waitcnt vmcnt(6)" ::: "memory"); __syncthreads();
    for (int i = 0; i < n; ++i) {
        const int cur = i % NBUF, k0 = (j0 + i) * KT;
        if (VAR != 1 && i + 2 < n) M2_STAGE((i + 2) % NBUF, k0 + 2 * KT);
        const bool full = DIR == 0 ? (k0 + KT - 1 <= rlo) : (k0 >= rhi);
        const bool none = DIR == 0 ? (k0 > rhi) : (k0 + KT - 1 < rlo);
        if (!none) {
            f32x4 p0 = {0.f, 0.f, 0.f, 0.f}, p1 = {0.f, 0.f, 0.f, 0.f};
            if (VAR != 3) { const char* Kc = K_lds + cur * SHM_K + n16 * 512;
#pragma unroll
              for (int s = 0; s < 8; ++s) { const int off = (64 * s + 16 * g) ^ ksw;
                  const bf16x8 a0 = *reinterpret_cast<const bf16x8*>(Kc + off), a1 = *reinterpret_cast<const bf16x8*>(Kc + 8192 + off);
                  p0 = __builtin_amdgcn_mfma_f32_16x16x32_bf16(a0, qr[s], p0, 0, 0, 0);
                  p1 = __builtin_amdgcn_mfma_f32_16x16x32_bf16(a1, qr[s], p1, 0, 0, 0); } }
            const f32x4 ga = *reinterpret_cast<const f32x4*>(Gf + k0 + 4 * g), gb = *reinterpret_cast<const f32x4*>(Gf + k0 + 16 + 4 * g);
            float ps = 0.f;
#pragma unroll
            for (int r = 0; r < 4; ++r) {
                float w0 = __builtin_amdgcn_exp2f(ga[r] - c2), w1 = __builtin_amdgcn_exp2f(gb[r] - c2);
                if (!full) { const int key = k0 + 4 * g + r;
                    const bool ok0 = DIR == 0 ? (key <= trow) : (key >= trow), ok1 = DIR == 0 ? (key + 16 <= trow) : (key + 16 >= trow);
                    w0 = ok0 ? w0 : 0.f; w1 = ok1 ? w1 : 0.f; }
                p0[r] *= w0; p1[r] *= w1; ps += p0[r] + p1[r]; }
            den += ps;
            u32x4 paw = {cvtpk(p0[0], p0[1]), cvtpk(p0[2], p0[3]), cvtpk(p1[0], p1[1]), cvtpk(p1[2], p1[3])};
            const bf16x8 pa = *reinterpret_cast<bf16x8*>(&paw);
            const int trv = trb + cur * SHM_V;
            SBAR();
            if (VAR != 2) M2_PV();
        }
        if (VAR != 1 && i + 2 < n) asm volatile("s_waitcnt vmcnt(6)" ::: "memory"); else asm volatile("s_waitcnt vmcnt(0)" ::: "memory");
        if (VAR != 4) __syncthreads();
    }
#undef M2_PV
#undef M2_WAIT0
#undef M2_WAIT8
#undef M2_MM4
#undef M2_RD4
#undef M2_MM
#undef M2_RD
#undef M2_STAGE
    den += __shfl_xor(den, 16); den += __shfl_xor(den, 32);
    if (g == 0) { li_l[n16] = den; ec_l[n16] = ec; }
    asm volatile("s_waitcnt lgkmcnt(0)" ::: "memory");
    float rs[4];
#pragma unroll
    for (int r = 0; r < 4; ++r) rs[r] = __builtin_amdgcn_rcpf(fmaxf(fabsf(li_l[4 * g + r]), ec_l[4 * g + r]));
    GAS bf16* Hw = (GAS bf16*)(Hb + (size_t)(wid * 16 + 4 * g) * DM + n16);
    asm volatile("" : "+v"(Hw));
#pragma unroll
    for (int sl = 0; sl < 4; ++sl)
#pragma unroll
        for (int cb = 0; cb < 8; ++cb)
#pragma unroll
            for (int r = 0; r < 4; ++r) { if (VAR != 5) Hw[(size_t)r * DM + sl * 128 + cb * 16] = (bf16)f2bf(o[sl * 8 + cb][r] * rs[r]); else asm volatile("" :: "v"(o[sl * 8 + cb][r] * rs[r])); }
    asm volatile("s_waitcnt lgkmcnt(0)" ::: "memory");
}

template <int VAR = 0>
__device__ __forceinline__ void phase(Frame& F) {
    const bf16* PROJ = (const bf16*)(F.ws + WS_PROJ); bf16* HS = (bf16*)(F.ws + (VAR ? WS_PSCR : WS_HS)); bf16* HS2 = (bf16*)(F.ws + (VAR ? WS_PSCR : WS_XB1)); bf16* HB = (bf16*)(F.ws + (VAR ? WS_PSCR : WS_HB));
    const float* hn = (const float*)F.in[5];
    const int G = F.G; const int x = blockIdx.x & 7, jx = blockIdx.x >> 3, per = G >> 3;
    const bool loc = (G % 8 == 0);
    for (int v = loc ? jx : (int)blockIdx.x; v < (loc ? 64 : 512); v += (loc ? per : G)) {
        const int bh = loc ? (4 * x + (v >> 4)) : (v >> 4), blk = v & 15;
        const int b = bh >> 2, h = bh & 3, r0u = blk * 128;
        const float* SC = (const float*)(F.ws + WS_SC) + (size_t)bh * 6 * SEQ;
        const bf16* rowb = PROJ + (size_t)(b * SEQ) * LD;
        const bf16* Qb = rowb + (size_t)r0u * LD + h * MDK;
        const bf16* Kh = rowb + 1024 + h * MDK;
        const bf16* Vh = rowb + 2048 + h * MDV;
        const size_t ho = (size_t)(b * SEQ + r0u) * DM + h * MDV;
        pass<0, (VAR > 0 ? VAR - 1 : 0)>(Qb, Kh, Vh, HS + ho, SC + 1 * SEQ, SC + 2 * SEQ, r0u, (char*)F.lds);
        pass<1, (VAR > 0 ? VAR - 1 : 0)>(Qb, Kh, Vh, HS2 + ho, SC + 4 * SEQ, SC + 5 * SEQ, r0u, (char*)F.lds);
        asm volatile("s_waitcnt vmcnt(0)" ::: "memory");
        { const int wid = F.wave, lane = F.lane;
          const f32x4 wa = *(const f32x4*)(hn + h * MDV + lane * 8), wb = *(const f32x4*)(hn + h * MDV + lane * 8 + 4);
          const float w[8] = {wa[0], wa[1], wa[2], wa[3], wb[0], wb[1], wb[2], wb[3]};
          for (int rr = 0; rr < 16; rr += 4) {
              u32x4 hv[4], hw[4], ov[4];
#pragma unroll
              for (int q = 0; q < 4; ++q) { const size_t ro = ho + (size_t)(wid * 16 + rr + q) * DM + lane * 8;
                  hv[q] = *(const u32x4*)(HS + ro); hw[q] = *(const u32x4*)(HS2 + ro);
                  ov[q] = *(const u32x4*)(PROJ + (size_t)(b * SEQ + r0u + wid * 16 + rr + q) * LD + 4096 + h * MDV + lane * 8); }
#pragma unroll
              for (int q = 0; q < 4; ++q) {
                  float v[8] = {bf_lo(hv[q].x) + bf_lo(hw[q].x), bf_hi(hv[q].x) + bf_hi(hw[q].x), bf_lo(hv[q].y) + bf_lo(hw[q].y), bf_hi(hv[q].y) + bf_hi(hw[q].y),
                                bf_lo(hv[q].z) + bf_lo(hw[q].z), bf_hi(hv[q].z) + bf_hi(hw[q].z), bf_lo(hv[q].w) + bf_lo(hw[q].w), bf_hi(hv[q].w) + bf_hi(hw[q].w)};
                  const float og[8] = {bf_lo(ov[q].x), bf_hi(ov[q].x), bf_lo(ov[q].y), bf_hi(ov[q].y), bf_lo(ov[q].z), bf_hi(ov[q].z), bf_lo(ov[q].w), bf_hi(ov[q].w)};
                  float ss = 0.f;
#pragma unroll
                  for (int k = 0; k < 8; ++k) ss += v[k] * v[k];
                  const float rstd = 1.0f / sqrtf(wave_sum(ss) * (1.0f / MDV) + NORM_EPS);
#pragma unroll
                  for (int k = 0; k < 8; ++k) v[k] = v[k] * rstd * w[k] * og[k];
                  u32x4 oo; oo.x = cvtpk(v[0], v[1]); oo.y = cvtpk(v[2], v[3]); oo.z = cvtpk(v[4], v[5]); oo.w = cvtpk(v[6], v[7]);
                  *(u32x4*)(HB + ho + (size_t)(wid * 16 + rr + q) * DM + lane * 8) = oo; }
          }
        }
    }
    __syncthreads();
}
}
namespace at {
#ifndef ATT_OUT_SCALE
#define ATT_OUT_SCALE 1.0f
#endif
constexpr int D = 128, QBLK = 32, KVBLK = 64;
constexpr float SCALE = 0.088388347648318440f;
constexpr float THR = 8.f;
constexpr int SDEPTH = 1;
constexpr int LDQ = APROJ, LDK = APROJ, LDO = DM;
constexpr int SHM_V = KVBLK * D * 2, SHM_K = KVBLK * D * 2, SHM_ATTN = 2 * SHM_V + 2 * SHM_K + NWAVES * 64 * 4;
static_assert(SHM_ATTN <= RING_BYTES, "attn LDS");
#define KSWZ(row, colB) ((row) * 256 + ((colB) ^ (((row) & 7) << 4)))

__device__ __forceinline__ void partialSM(f32x16& p0, f32x16& p1, float& m_reg, float& mn, float& alpha) {
    constexpr float C = SCALE * 1.4426950408889634f;
    float pmax = p0[0];
#pragma unroll
    for (int r = 1; r < 16; ++r) pmax = fmaxf(pmax, p0[r]);
#pragma unroll
    for (int r = 0; r < 16; ++r) pmax = fmaxf(pmax, p1[r]);
    { auto rr = __builtin_amdgcn_permlane32_swap(__float_as_uint(pmax), __float_as_uint(pmax), false, false);
      pmax = fmaxf(__uint_as_float(rr[0]), __uint_as_float(rr[1])); }
    if (__builtin_expect(__all(pmax - m_reg <= THR / SCALE), 1)) { mn = m_reg; alpha = 1.f; }
    else { mn = fmaxf(m_reg, pmax); alpha = __builtin_amdgcn_exp2f((m_reg - mn) * C); m_reg = mn; }
    const float mnC = -mn * C;
#pragma unroll
    for (int r = 0; r < 16; ++r) p0[r] = fmaf(p0[r], C, mnC);
#pragma unroll
    for (int r = 0; r < 16; ++r) p1[r] = fmaf(p1[r], C, mnC);
#pragma unroll
    for (int r = 0; r < 16; ++r) p0[r] = __builtin_amdgcn_exp2f(p0[r]);
}
__device__ __forceinline__ void finishSM(f32x16& p0, f32x16& p1, float alpha, float& l_reg, bf16x8& pa0, bf16x8& pa1, bf16x8& pa2, bf16x8& pa3) {
#pragma unroll
    for (int r = 0; r < 16; ++r) p1[r] = __builtin_amdgcn_exp2f(p1[r]);
    float ps = 0;
#pragma unroll
    for (int r = 0; r < 16; ++r) ps += p0[r];
#pragma unroll
    for (int r = 0; r < 16; ++r) ps += p1[r];
    { auto rr = __builtin_amdgcn_permlane32_swap(__float_as_uint(ps), __float_as_uint(ps), false, false);
      ps = __uint_as_float(rr[0]) + __uint_as_float(rr[1]); }
    l_reg = l_reg * alpha + ps;
    PK4(p0, 0, pa0); PK4(p0, 8, pa1); PK4(p1, 0, pa2); PK4(p1, 8, pa3);
}
__device__ __forceinline__ void attn_dense_body(const bf16* __restrict__ Qb, const bf16* __restrict__ Kh, const bf16* __restrict__ Vh, bf16* __restrict__ Ob, int seq, char* lds) {
    const int tid = opaque_tid(), wid = tid >> 6, lane = tid & 63, r32 = lane & 31, hi = lane >> 5;
    char* V_lds = lds; char* K_lds = lds + 2 * SHM_V;
    float* wsf = (float*)(lds + 2 * SHM_V + 2 * SHM_K) + wid * 64; float* li_l = wsf; float* al_l = wsf + 32;
    float m_reg = -1e30f, l_reg = 0; f32x16 o[4] = {}; bf16x8 qr[8];
    const bf16* Qw = Qb + (long)(wid * QBLK + r32) * LDQ + hi * 8;
#pragma unroll
    for (int d0 = 0; d0 < 8; ++d0) qr[d0] = *reinterpret_cast<const bf16x8*>(Qw + d0 * 16);
    const int sr = tid >> 4, sc = (tid & 15) * 8, vst0 = v_st(sr, sc), vst1 = v_st(32 + sr, sc);
    const int vb0 = (int)(uintptr_t)V_lds + v_rd_base(lane);
    struct { bf16x8 vs0, vs1, ks0, ks1; } sr_[SDEPTH];
#define SLOAD(i, k0) do { sr_[i].vs0 = *reinterpret_cast<const bf16x8*>(&Vh[(long)((k0) + sr) * LDK + sc]); sr_[i].vs1 = *reinterpret_cast<const bf16x8*>(&Vh[(long)((k0) + 32 + sr) * LDK + sc]); \
    sr_[i].ks0 = *reinterpret_cast<const bf16x8*>(&Kh[(long)((k0) + sr) * LDK + sc]); sr_[i].ks1 = *reinterpret_cast<const bf16x8*>(&Kh[(long)((k0) + 32 + sr) * LDK + sc]); } while (0)
#define SWRITE(b, i) do { *(bf16x8*)(V_lds + (b) * SHM_V + vst0) = sr_[i].vs0;          \
    *(bf16x8*)(V_lds + (b) * SHM_V + vst1) = sr_[i].vs1; int kc_ = sc * 2;               \
    *(bf16x8*)(K_lds + (b) * SHM_K + KSWZ(sr, kc_)) = sr_[i].ks0;                       \
    *(bf16x8*)(K_lds + (b) * SHM_K + KSWZ(32 + sr, kc_)) = sr_[i].ks1; } while (0)
#define SWAIT() do { if constexpr (SDEPTH == 2) asm volatile("s_waitcnt vmcnt(4)" ::: "memory"); else asm volatile("s_waitcnt vmcnt(0)" ::: "memory"); } while (0)
#define RESC(a) do { if (__any((a) < 1.f)) { if (hi == 0) al_l[r32] = (a); asm volatile("s_waitcnt lgkmcnt(0)" ::: "memory"); \
    _Pragma("unroll") for (int d = 0; d < 4; ++d) _Pragma("unroll") for (int r = 0; r < 16; ++r) o[d][r] *= al_l[crow(r, hi)]; } } while (0)
    f32x16 pA0, pA1, pB0, pB1; float mnA, mnB, alA, alB; bf16x8 pa0, pa1, pa2, pa3; const int NT = seq / KVBLK;
    constexpr int SE = 0, SO = SDEPTH - 1;
    SLOAD(SE, 0); asm volatile("s_waitcnt vmcnt(0)" ::: "memory"); SWRITE(0, SE); __syncthreads();
    qkt<8, 256>(pA0, pA1, K_lds, qr, r32, hi); partialSM(pA0, pA1, m_reg, mnA, alA);
    SLOAD(SO, KVBLK); if constexpr (SDEPTH == 2) { if (2 < NT) SLOAD(SE, 2 * KVBLK); }
    SWAIT(); SWRITE(1, SO); __syncthreads();
    for (int j = 1; j + 1 < NT; j += 2) {
        SBAR(); qkt<8, 256>(pB0, pB1, K_lds + SHM_K, qr, r32, hi);
        finishSM(pA0, pA1, alA, l_reg, pa0, pa1, pa2, pa3); SBAR();
        SLOAD(SO, (j + SDEPTH) * KVBLK); SBAR();
        pv_d0(o, vb0, pa0, pa1, pa2, pa3); partialSM(pB0, pB1, m_reg, mnB, alB);
        __syncthreads(); SWAIT(); SWRITE(0, SE);
        RESC(alB); __syncthreads();
        SBAR(); qkt<8, 256>(pA0, pA1, K_lds, qr, r32, hi);
        finishSM(pB0, pB1, alB, l_reg, pa0, pa1, pa2, pa3); SBAR();
        if (SDEPTH == 1 || j + 3 < NT) SLOAD(SE, (j + 1 + SDEPTH) * KVBLK); SBAR();
        pv_d0(o, vb0 + (int)SHM_V, pa0, pa1, pa2, pa3); partialSM(pA0, pA1, m_reg, mnA, alA);
        __syncthreads(); SWAIT(); SWRITE(1, SO);
        RESC(alA); __syncthreads();
    }
    SBAR(); qkt<8, 256>(pB0, pB1, K_lds + SHM_K, qr, r32, hi);
    finishSM(pA0, pA1, alA, l_reg, pa0, pa1, pa2, pa3); SBAR();
    pv_d0(o, vb0, pa0, pa1, pa2, pa3); partialSM(pB0, pB1, m_reg, mnB, alB);
    __syncthreads(); RESC(alB);
    finishSM(pB0, pB1, alB, l_reg, pa0, pa1, pa2, pa3); SBAR();
    pv_d0(o, vb0 + (int)SHM_V, pa0, pa1, pa2, pa3);
    if (hi == 0) li_l[r32] = l_reg; asm volatile("s_waitcnt lgkmcnt(0)" ::: "memory");
    float rli[16];
#pragma unroll
    for (int r = 0; r < 16; ++r) rli[r] = __builtin_amdgcn_rcpf(li_l[crow(r, hi)]);
    bf16* Ow = Ob + (long)(wid * QBLK) * LDO;
#pragma unroll
    for (int r = 0; r < 16; ++r) { const int orow = crow(r, hi);
#pragma unroll
        for (int d0 = 0; d0 < 4; ++d0) Ow[(long)orow * LDO + d0 * 32 + r32] = (bf16)f2bf(o[d0][r] * rli[r] * ATT_OUT_SCALE); }
    asm volatile("s_waitcnt lgkmcnt(0)" ::: "memory");
    __syncthreads();
#undef SLOAD
#undef SWRITE
#undef SWAIT
#undef RESC
}
__device__ __forceinline__ void rope_phase(Frame& F) {
    bf16* P = (bf16*)(F.ws + WS_PROJ);
    const float* qn = (const float*)F.in[8]; const float* kn = (const float*)F.in[9];
    const float* cosT = (const float*)(F.ws + WS_ROPE); const float* sinT = cosT + SEQ * 64;
    const float* part = (const float*)(F.ws + WS_PART);
    const int gw = blockIdx.x * NWAVES + F.wave, NGW = F.G * NWAVES, lane = F.lane;
    const float q0 = qn[2 * lane], q1 = qn[2 * lane + 1], k0 = kn[2 * lane], k1 = kn[2 * lane + 1];
    unsigned wn[24]; float ppn = 0.f, cn = 0.f, sn = 0.f;
    if (gw < TOK) { const unsigned* p0 = (const unsigned*)(P + (size_t)gw * APROJ) + lane;
#pragma unroll
        for (int hs = 0; hs < 24; ++hs) wn[hs] = p0[hs * 64];
        ppn = lane < 32 ? part[(size_t)gw * 32 + lane] : 0.f; cn = cosT[(gw & (SEQ - 1)) * 64 + lane]; sn = sinT[(gw & (SEQ - 1)) * 64 + lane]; }
    for (int tok = gw; tok < TOK; tok += NGW) {
        unsigned* p = (unsigned*)(P + (size_t)tok * APROJ) + lane;
        unsigned w[24];
#pragma unroll
        for (int hs = 0; hs < 24; ++hs) w[hs] = wn[hs];
        const float pp = ppn, c = cn, s = sn;
        { const int tn = (tok + NGW < TOK) ? tok + NGW : tok; const unsigned* pn = (const unsigned*)(P + (size_t)tn * APROJ) + lane;
#pragma unroll
          for (int hs = 0; hs < 24; ++hs) wn[hs] = pn[hs * 64];
          ppn = lane < 32 ? part[(size_t)tn * 32 + lane] : 0.f; cn = cosT[(tn & (SEQ - 1)) * 64 + lane]; sn = sinT[(tn & (SEQ - 1)) * 64 + lane]; }
        const float r2 = 1.0f / (wave_sum(pp) * (1.0f / DM) + NORM_EPS);
        const float rstd = sqrtf(r2), epsq = NORM_EPS / r2;
#pragma unroll
        for (int hs = 0; hs < 24; ++hs) {
            const float x1 = bf_lo(w[hs]), x2 = bf_hi(w[hs]);
            if (hs >= 20) { p[hs * 64] = cvtpk(x1 * rstd, x2 * rstd); continue; }
            const float rs = 1.0f / sqrtf(wave_sum(x1 * x1 + x2 * x2) * (1.0f / 128.0f) + epsq);
            const float y1 = x1 * rs * (hs < 16 ? q0 : k0), y2 = x2 * rs * (hs < 16 ? q1 : k1);
            p[hs * 64] = cvtpk(y1 * c - y2 * s, y1 * s + y2 * c);
        }
    }
}
__device__ __forceinline__ void phase(Frame& F) {
    const bf16* P = (const bf16*)(F.ws + WS_PROJ); bf16* OB = (bf16*)(F.ws + WS_HB);
    const int G = F.G; const int x = blockIdx.x & 7, jx = blockIdx.x >> 3, per = G >> 3;
    for (int u = (G % 8 == 0) ? (x * per + jx) : (int)blockIdx.x; u < 1024; u += G) {
        const int bk = u >> 5, hg = (u >> 3) & 3, qb = u & 7, b = bk >> 2, kvh = bk & 3, h = kvh * 4 + hg;
        const bf16* rowb = P + (size_t)(b * SEQ) * APROJ;
        attn_dense_body(rowb + (size_t)(qb * 256) * APROJ + h * D, rowb + 2048 + kvh * D, rowb + 2560 + kvh * D,
                        OB + (size_t)(b * SEQ + qb * 256) * DM + h * D, SEQ, (char*)F.lds);
    }
}
}
namespace tk {
constexpr int OFF_K1 = 0, OFF_K2 = 32768, OFF_SCR = 65536;
static_assert(OFF_SCR + NWAVES * 4096 <= RING_BYTES, "topk LDS");
__device__ __forceinline__ void ce(unsigned& a, unsigned& b) { const unsigned mx = a > b ? a : b, mn = a > b ? b : a; a = mx; b = mn; }
__device__ __forceinline__ void sort16(unsigned (&k)[16]) {
#define TK_CE(a, b) ce(k[a], k[b]);
    TK_CE(0, 13) TK_CE(1, 12) TK_CE(2, 15) TK_CE(3, 14) TK_CE(4, 8) TK_CE(5, 6) TK_CE(7, 11) TK_CE(9, 10)
    TK_CE(0, 5) TK_CE(1, 7) TK_CE(2, 9) TK_CE(3, 4) TK_CE(6, 13) TK_CE(8, 14) TK_CE(10, 15) TK_CE(11, 12)
    TK_CE(0, 1) TK_CE(2, 3) TK_CE(4, 5) TK_CE(6, 8) TK_CE(7, 9) TK_CE(10, 11) TK_CE(12, 13) TK_CE(14, 15)
    TK_CE(0, 2) TK_CE(1, 3) TK_CE(4, 10) TK_CE(5, 11) TK_CE(6, 7) TK_CE(8, 9) TK_CE(12, 14) TK_CE(13, 15)
    TK_CE(1, 2) TK_CE(3, 12) TK_CE(4, 6) TK_CE(5, 7) TK_CE(8, 10) TK_CE(9, 11) TK_CE(13, 14)
    TK_CE(1, 4) TK_CE(2, 6) TK_CE(5, 8) TK_CE(7, 10) TK_CE(9, 13) TK_CE(11, 14)
    TK_CE(2, 4) TK_CE(3, 6) TK_CE(9, 12) TK_CE(11, 13)
    TK_CE(3, 5) TK_CE(6, 8) TK_CE(7, 9) TK_CE(10, 12)
    TK_CE(3, 4) TK_CE(5, 6) TK_CE(7, 8) TK_CE(9, 10) TK_CE(11, 12)
    TK_CE(6, 7) TK_CE(8, 9)
#undef TK_CE
}
__device__ __forceinline__ void merge16(unsigned (&a)[16], const unsigned (&b)[16]) {
#pragma unroll
    for (int i = 0; i < 16; ++i) a[i] = a[i] > b[15 - i] ? a[i] : b[15 - i];
#pragma unroll
    for (int st = 8; st > 0; st >>= 1)
#pragma unroll
        for (int i = 0; i < 16; ++i) { const int j = i ^ st; if (j > i) ce(a[i], a[j]); }
}
__device__ __forceinline__ void xmerge16(unsigned (&a)[16]) {
    unsigned x[16], y[16];
#pragma unroll
    for (int i = 0; i < 16; ++i) { auto rr = __builtin_amdgcn_permlane32_swap(a[i], a[i], false, false); x[i] = rr[0]; y[i] = rr[1]; }
    merge16(x, y);
#pragma unroll
    for (int i = 0; i < 16; ++i) a[i] = x[i];
}
__device__ __forceinline__ unsigned f2key(float f) { const unsigned u = __float_as_uint(f); return u ^ ((unsigned)((int)u >> 31) | 0x80000000u); }
__device__ __forceinline__ float key2f(unsigned k, unsigned mask) { k &= ~mask; const unsigned u = (k & 0x80000000u) ? (k ^ 0x80000000u) : ~k; return __uint_as_float(u & ~mask); }
template <int VAR>
__device__ __forceinline__ void half_topk(unsigned (&t)[16], const bf16* qrow, const char* Kl, int r32, int hi) {
    bf16x8 qr[8];
#pragma unroll
    for (int d0 = 0; d0 < 8; ++d0) qr[d0] = *reinterpret_cast<const bf16x8*>(qrow + d0 * 16);
    f32x16 a0, a1, a2, a3;
    if (VAR != 3) { qkt<8, 256>(a0, a1, Kl, qr, r32, hi); qkt<8, 256>(a2, a3, Kl + 64 * 256, qr, r32, hi); }
    else { a0 = f32x16{}; a1 = a0; a2 = a0; a3 = a0; a0[0] = __uint_as_float((unsigned)qr[0][0]); a1[1] = __uint_as_float((unsigned)qr[7][1]); }
    unsigned kb[16], kc[16], kd[16];
#pragma unroll
    for (int r = 0; r < 16; ++r) { const unsigned base = 127u - (unsigned)((r & 3) + 8 * (r >> 2)) - 4u * (unsigned)hi;
        t[r]  = (f2key(a0[r]) & ~127u) | (base);
        kb[r] = (f2key(a1[r]) & ~127u) | (base - 32u);
        kc[r] = (f2key(a2[r]) & ~127u) | (base - 64u);
        kd[r] = (f2key(a3[r]) & ~127u) | (base - 96u); }
    if (VAR != 2) { sort16(t); sort16(kb); sort16(kc); sort16(kd);
    merge16(t, kb); merge16(kc, kd); merge16(t, kc);
    xmerge16(t); } else { for (int r = 0; r < 16; ++r) t[r] ^= kb[r] + kc[r] + kd[r]; }
}
struct Cand { int i, j; };
constexpr Cand cand_at(int n) {
    int c = 0;
    for (int i = 0; i < 16; ++i) for (int j = 0; j < 16; ++j) if ((i + 1) * (j + 1) <= 16) { if (c == n) return Cand{i, j}; ++c; }
    return Cand{0, 0};
}
template <int N> __device__ __forceinline__ unsigned cand_key(const float (&v1)[16], const float (&v2)[16], int hi) {
    constexpr Cand A = cand_at(N), B = cand_at(25 + N);
    const float s = hi ? (v1[B.i] + v2[B.j]) : (v1[A.i] + v2[A.j]);
    const unsigned pl = hi ? (unsigned)(B.i * 16 + B.j) : (unsigned)(A.i * 16 + A.j);
    return (f2key(s) & ~255u) | pl;
}
template <int N> struct CandFill { static __device__ __forceinline__ void run(unsigned (&c)[32], const float (&v1)[16], const float (&v2)[16], int hi) { c[N] = cand_key<N>(v1, v2, hi); CandFill<N + 1>::run(c, v1, v2, hi); } };
template <> struct CandFill<25> { static __device__ __forceinline__ void run(unsigned (&)[32], const float (&)[16], const float (&)[16], int) {} };
template <int VAR = 0>
__device__ __forceinline__ void phase(Frame& F, int layer, const bf16* PQ) {
    const int tid = F.tid, wid = F.wave, lane = F.lane, r32 = lane & 31, hi = lane >> 5;
    char* lds = (char*)F.lds;
    const bf16* pk = (const bf16*)(F.ws + WS_PK) + (size_t)layer * 2 * PKEYS * PHALF;
    const float* part = (const float*)(F.ws + WS_PART);
    int* idx_out = (int*)(F.ws + (VAR ? WS_PSCR : WS_IDX)); float* gate_out = (float*)(F.ws + (VAR ? WS_PSCR + 16 * MiB : WS_GSM));
    __syncthreads();
#pragma unroll
    for (int i = 0; i < 8; ++i) { const int c = tid + NTHREADS * i, which = c >> 11, rc = c & 2047, row = rc >> 4, ch = rc & 15;
        const u32x4 v = *(const u32x4*)(pk + (size_t)which * PKEYS * PHALF + row * PHALF + ch * 8);
        *(u32x4*)(lds + which * 32768 + row * 256 + ((ch * 16) ^ ((row & 7) << 4))) = v; }
    __syncthreads();
    int* scr = (int*)(lds + OFF_SCR + wid * 4096) + r32 * 32;
    for (int unit = blockIdx.x; unit < TOK / 32; unit += F.G) {
        const int tok = unit * 32 + r32, head = wid;
        const bf16* qrow = PQ + (size_t)tok * DM + head * 256 + hi * 8;
        float ssq = 0.f;
#pragma unroll
        for (int q = 0; q < 8; ++q) { const f32x4 pp = *(const f32x4*)(part + (size_t)tok * 32 + q * 4); ssq += (pp[0] + pp[1]) + (pp[2] + pp[3]); }
        unsigned t1[16], t2[16];
        half_topk<VAR>(t1, qrow, lds + OFF_K1, r32, hi);
        half_topk<VAR>(t2, qrow + PHALF, lds + OFF_K2, r32, hi);
        float v1[16], v2[16];
#pragma unroll
        for (int i = 0; i < 16; ++i) { v1[i] = key2f(t1[i], 127u); v2[i] = key2f(t2[i], 127u); }
        if (hi == 0) {
#pragma unroll
            for (int i = 0; i < 16; ++i) { scr[i] = 127 - (int)(t1[i] & 127u); scr[16 + i] = 127 - (int)(t2[i] & 127u); }
        }
        unsigned cc[32];
#pragma unroll
        for (int n = 25; n < 32; ++n) cc[n] = 0u;
        CandFill<0>::run(cc, v1, v2, hi);
        unsigned ca[16], cb[16];
#pragma unroll
        for (int n = 0; n < 16; ++n) { ca[n] = cc[n]; cb[n] = cc[16 + n]; }
        if (VAR != 2) { sort16(ca); sort16(cb); merge16(ca, cb); xmerge16(ca); } else { for (int n = 0; n < 16; ++n) ca[n] ^= cb[n]; }
        const float rstd = 1.0f / sqrtf(ssq * (1.0f / DM) + NORM_EPS);
        float e[16]; float esum = 0.f; const float top = key2f(ca[0], 255u);
#pragma unroll
        for (int k = 0; k < 16; ++k) { e[k] = __expf((key2f(ca[k], 255u) - top) * rstd); esum += e[k]; }
        const float inv = 1.0f / esum;
        asm volatile("s_waitcnt lgkmcnt(0)" ::: "memory");
        int eo[8]; float go[8];
#pragma unroll
        for (int k = 0; k < 8; ++k) { const unsigned key = hi ? ca[8 + k] : ca[k]; const int pl = (int)(key & 255u);
            eo[k] = scr[pl >> 4] * PKEYS + scr[16 + (pl & 15)]; go[k] = (hi ? e[8 + k] : e[k]) * inv; }
        unsigned* io = (unsigned*)idx_out + (size_t)tok * (PE / 2) + head * 8 + hi * 4; float* gg = gate_out + (size_t)tok * PE + head * 16 + hi * 8;
        *(u32x4*)io = (u32x4){(unsigned)eo[0] | ((unsigned)eo[1] << 16), (unsigned)eo[2] | ((unsigned)eo[3] << 16), (unsigned)eo[4] | ((unsigned)eo[5] << 16), (unsigned)eo[6] | ((unsigned)eo[7] << 16)};
        *(f32x4*)gg = (f32x4){go[0], go[1], go[2], go[3]}; *(f32x4*)(gg + 4) = (f32x4){go[4], go[5], go[6], go[7]};
        asm volatile("s_waitcnt lgkmcnt(0)" ::: "memory");
    }
    __syncthreads();
}
}

namespace pg {
__device__ __forceinline__ float gelu_tanh(float x) {
    const float u = 0.7978845608028654f * (x + 0.044715f * x * x * x);
    const float e = __expf(2.0f * u); const float th = 1.0f - 2.0f * __builtin_amdgcn_rcpf(e + 1.0f);
    return 0.5f * x * (1.0f + th);
}
struct Place { int ord, nx, lw, nlw; };
constexpr int NSL4 = 8, SLW4 = 256, SLB4 = 128;
typedef int i32x8 __attribute__((ext_vector_type(8)));
template <int VAR>
__device__ __forceinline__ void phase_u4(Frame& F, const Place& pl, int layer, const bf16* xbin, float* P) {
    const int lane = F.lane, j = lane >> 3, c = lane & 7, i16 = lane & 15, g = lane >> 4;
    const unsigned char* ub = (const unsigned char*)(F.ws + WS_UB) + (size_t)layer * PEXP * (DM / 2);
    const __amdgpu_buffer_rsrc_t irs = __builtin_amdgcn_make_buffer_rsrc((void*)(F.ws + WS_IDX), 0, TOK * PE * 2, 0x00020000);
    const __amdgpu_buffer_rsrc_t xrs = __builtin_amdgcn_make_buffer_rsrc((void*)xbin, 0, TOK * DM * 2, 0x00020000);
    const __amdgpu_buffer_rsrc_t prs = __builtin_amdgcn_make_buffer_rsrc((void*)P, 0, TOK * NSL4 * PE * 4, 0x00020000);
    const int bsrc = (j >> 1) * 4, bsh = (j & 1) * 16;
    const int tile = (int)(uintptr_t)((char*)F.lds) + F.wave * 16384, xs = (int)(uintptr_t)((char*)F.lds) + 131072 + F.wave * 256;
    const int wr0 = tile + j * 128 + ((c ^ (j >> 1)) * 16), wr1 = tile + j * 128 + ((c ^ (4 + (j >> 1))) * 16);
    const int ard0 = tile + i16 * 128 + ((g ^ (i16 >> 1)) * 16), ard1 = tile + i16 * 128 + (((4 + g) ^ (i16 >> 1)) * 16);
    for (int s = pl.ord; s < NSL4; s += pl.nx) {
        const __amdgpu_buffer_rsrc_t rs = __builtin_amdgcn_make_buffer_rsrc((void*)(ub + (size_t)s * PEXP * SLB4), 0, PEXP * SLB4, 0x00020000);
        u32x4 rA[16], rB[16]; u32x2 xA, xB;
        unsigned idwA = __builtin_amdgcn_raw_buffer_load_b32(irs, (pl.lw * (PE / 2) + lane) * 4, 0, 0), idwB = 0;
#define PU_ISSUE(r, xr, t, idw, idnext) do { __builtin_amdgcn_sched_barrier(0); \
            { const int tn_ = ((t) + pl.nlw < TOK) ? (t) + pl.nlw : (t); idnext = __builtin_amdgcn_raw_buffer_load_b32(irs, (tn_ * (PE / 2) + lane) * 4, 0, 0); } asm volatile("" ::: "memory"); \
            _Pragma("unroll") for (int b = 0; b < 16; ++b) { const int e_ = (int)((unsigned)__builtin_amdgcn_ds_bpermute(bsrc + 16 * b, (int)idw) >> bsh) & (VAR == 2 ? 0x3ff : 0xffff); \
                if (VAR == 3) r[b] = (u32x4){(unsigned)e_, 1u, 2u, 3u}; else r[b] = __builtin_amdgcn_raw_buffer_load_b128(rs, e_ * SLB4 + c * 16, 0, 0); } \
            xr = __builtin_amdgcn_raw_buffer_load_b64(xrs, ((t) * DM + s * SLW4 + 4 * lane) * 2, 0, 0); \
            asm volatile("" ::: "memory"); __builtin_amdgcn_sched_barrier(0); } while (0)
#define PU_MF(beta, ad, bq) { const u32x4 a_ = *(LAS u32x4*)(uintptr_t)(unsigned)((ad) + 2048 * (beta)); \
            acc[beta] = __builtin_amdgcn_mfma_scale_f32_16x16x128_f8f6f4((i32x8){(int)a_.x, (int)a_.y, (int)a_.z, (int)a_.w, 0, 0, 0, 0}, bq, acc[beta], 4, 0, 0, 0x7f7f7f7f, 0, 0x7f7f7f7f); }
#define PU_COMPUTE(r, xr, t, valid) do { \
            if (VAR == 1) { u32x4 z_ = r[0]; _Pragma("unroll") for (int b = 1; b < 16; ++b) z_ = z_ ^ r[b]; z_.x ^= xr.x ^ xr.y; \
                __builtin_amdgcn_raw_buffer_store_b128(z_, prs, (i16 < 8 && (valid)) ? (((t) * NSL4 + s) * PE + 16 * i16 + 4 * g) * 4 : 0x7ffffff0, 0, 0); break; } \
            _Pragma("unroll") for (int b = 0; b < 16; ++b) *(LAS u32x4*)(uintptr_t)(unsigned)(((b & 1) ? wr1 : wr0) + 1024 * b) = r[b]; \
            { const float x0 = __uint_as_float(xr.x << 16), x1 = __uint_as_float(xr.x & 0xffff0000u), x2 = __uint_as_float(xr.y << 16), x3 = __uint_as_float(xr.y & 0xffff0000u); \
              int pk = __builtin_amdgcn_cvt_pk_fp8_f32(__builtin_amdgcn_fmed3f(x0, -448.f, 448.f), __builtin_amdgcn_fmed3f(x1, -448.f, 448.f), 0, false); \
              pk = __builtin_amdgcn_cvt_pk_fp8_f32(__builtin_amdgcn_fmed3f(x2, -448.f, 448.f), __builtin_amdgcn_fmed3f(x3, -448.f, 448.f), pk, true); \
              *(LAS unsigned*)(uintptr_t)(unsigned)(xs + 4 * lane) = (unsigned)pk; } \
              \
            const u32x4 b00 = *(LAS u32x4*)(uintptr_t)(unsigned)(xs + 16 * g), b01 = *(LAS u32x4*)(uintptr_t)(unsigned)(xs + 64 + 16 * g); \
            const u32x4 b10 = *(LAS u32x4*)(uintptr_t)(unsigned)(xs + 128 + 16 * g), b11 = *(LAS u32x4*)(uintptr_t)(unsigned)(xs + 192 + 16 * g); \
            const i32x8 bq0 = {(int)b00.x, (int)b00.y, (int)b00.z, (int)b00.w, (int)b01.x, (int)b01.y, (int)b01.z, (int)b01.w}; \
            const i32x8 bq1 = {(int)b10.x, (int)b10.y, (int)b10.z, (int)b10.w, (int)b11.x, (int)b11.y, (int)b11.z, (int)b11.w}; \
            f32x4 acc[8]; \
            _Pragma("unroll") for (int be = 0; be < 8; ++be) acc[be] = (f32x4){0.f, 0.f, 0.f, 0.f}; \
            _Pragma("unroll") for (int be = 0; be < 8; ++be) PU_MF(be, ard0, bq0) \
            _Pragma("unroll") for (int be = 0; be < 8; ++be) PU_MF(be, ard1, bq1) \
            f32x4 o_ = acc[0]; \
            _Pragma("unroll") for (int be = 1; be < 8; ++be) { const bool m_ = (i16 == be); o_[0] = m_ ? acc[be][0] : o_[0]; o_[1] = m_ ? acc[be][1] : o_[1]; o_[2] = m_ ? acc[be][2] : o_[2]; o_[3] = m_ ? acc[be][3] : o_[3]; } \
            __builtin_amdgcn_raw_buffer_store_b128((u32x4){__float_as_uint(o_[0]), __float_as_uint(o_[1]), __float_as_uint(o_[2]), __float_as_uint(o_[3])}, prs, \
                                                   (i16 < 8 && (valid)) ? (((t) * NSL4 + s) * PE + 16 * i16 + 4 * g) * 4 : 0x7ffffff0, 0, 0);        \
            asm volatile("s_waitcnt lgkmcnt(0)" ::: "memory"); } while (0)
        PU_ISSUE(rA, xA, pl.lw, idwA, idwB);
        for (int t = pl.lw; t < TOK; t += 2 * pl.nlw) {
            const bool vB = t + pl.nlw < TOK; const int tB = vB ? t + pl.nlw : t, tA2 = (t + 2 * pl.nlw < TOK) ? t + 2 * pl.nlw : t;
            PU_ISSUE(rB, xB, tB, idwB, idwA);
            PU_COMPUTE(rA, xA, t, true);
            PU_ISSUE(rA, xA, tA2, idwA, idwB);
            PU_COMPUTE(rB, xB, tB, vB);
        }
#undef PU_ISSUE
#undef PU_MF
#undef PU_COMPUTE
    }
}
template <int NSLU, int U4>
__device__ __forceinline__ void phase_r(Frame& F, const float* P) {
    const int lane = F.lane, l32 = lane & 31;
    const float* part = (const float*)(F.ws + WS_PART); const float* gate = (const float*)(F.ws + WS_GSM); float* wout = (float*)(F.ws + WS_HB);
    const int gw = blockIdx.x * NWAVES + F.wave, NGW = F.G * NWAVES;
    constexpr int NT = 4;
    for (int t0 = gw; t0 < TOK; t0 += NT * NGW) {
        f32x4 v[NT][NSLU / 2]; float pp[NT]; f32x4 g[NT]; u32x2 ids[NT];
#pragma unroll
        for (int u = 0; u < NT; ++u) { const int t = (t0 + u * NGW < TOK) ? t0 + u * NGW : t0;
            const f32x4* base = (const f32x4*)(P + (size_t)t * NSLU * PE) + lane;
#pragma unroll
            for (int i = 0; i < NSLU / 2; ++i) v[u][i] = base[64 * i];
            pp[u] = lane < 32 ? part[(size_t)t * 32 + lane] : 0.f;
            g[u] = *(const f32x4*)(gate + (size_t)t * PE + l32 * 4);
            ids[u] = *(const u32x2*)((const unsigned*)(F.ws + WS_IDX) + (size_t)t * (PE / 2) + l32 * 2); }
#pragma unroll
        for (int u = 0; u < NT; ++u) { const int t = t0 + u * NGW;
            const float rstd = (1.0f / (U4 ? PEER_U4_SCALE : PEER_U_SCALE)) / sqrtf(wave_sum(pp[u]) * (1.0f / DM) + NORM_EPS);
            f32x4 a = v[u][0];
#pragma unroll
            for (int i = 1; i < NSLU / 2; ++i) a += v[u][i];
            a[0] += __shfl_xor(a[0], 32); a[1] += __shfl_xor(a[1], 32); a[2] += __shfl_xor(a[2], 32); a[3] += __shfl_xor(a[3], 32);
            const float vs = 1.0f / PEER_V_SCALE;
            const f32x4 w = {vs * g[u][0] * gelu_tanh(a[0] * rstd), vs * g[u][1] * gelu_tanh(a[1] * rstd), vs * g[u][2] * gelu_tanh(a[2] * rstd), vs * g[u][3] * gelu_tanh(a[3] * rstd)};
            if (lane < 32 && t < TOK) {
                const unsigned w01 = cvtpk(w[0], w[1]), w23 = cvtpk(w[2], w[3]);
                *(u32x4*)((unsigned*)wout + (size_t)t * PE + l32 * 4) = (u32x4){(w01 << 16) | (ids[u].x & 0xffffu), (w01 & 0xffff0000u) | (ids[u].x >> 16), (w23 << 16) | (ids[u].y & 0xffffu), (w23 & 0xffff0000u) | (ids[u].y >> 16)};
                { const float ws_ = PEER_V_SCALE * PEER_W_SCALE;
                  int pk = __builtin_amdgcn_cvt_pk_fp8_f32(fminf(fmaxf(w[0] * ws_, -448.f), 448.f), fminf(fmaxf(w[1] * ws_, -448.f), 448.f), 0, false);
                  pk = __builtin_amdgcn_cvt_pk_fp8_f32(fminf(fmaxf(w[2] * ws_, -448.f), 448.f), fminf(fmaxf(w[3] * ws_, -448.f), 448.f), pk, true);
                  *(unsigned*)((unsigned char*)(F.ws + WS_HB + 8 * MiB) + (size_t)t * PE + l32 * 4) = (unsigned)pk; } } }
    }
}
constexpr float PEER_V4_SCALE = 5.656854249f;
__device__ __forceinline__ void phase_v4(Frame& F, const Place& pl, int layer, const bf16* xin, float* xout, bf16* xbout, float* part2) {
    const int lane = F.lane, j = lane >> 3, c = lane & 7, n16 = lane & 15, g = lane >> 4;
    const unsigned char* vb = (const unsigned char*)(F.ws + WS_VB) + (size_t)layer * PEXP * (DM / 2);
    const __amdgpu_buffer_rsrc_t wrs = __builtin_amdgcn_make_buffer_rsrc((void*)(F.ws + WS_HB), 0, TOK * PE * 4, 0x00020000);
    const __amdgpu_buffer_rsrc_t frs = __builtin_amdgcn_make_buffer_rsrc((void*)(F.ws + WS_HB + 8 * MiB), 0, TOK * PE, 0x00020000);
    const __amdgpu_buffer_rsrc_t xirs = __builtin_amdgcn_make_buffer_rsrc((void*)xin, 0, TOK * DM * 2, 0x00020000);
    const __amdgpu_buffer_rsrc_t xors = __builtin_amdgcn_make_buffer_rsrc((void*)(xout ? (void*)xout : (void*)xin), 0, xout ? TOK * DM * 4 : 0, 0x00020000);
    const __amdgpu_buffer_rsrc_t xbrs = __builtin_amdgcn_make_buffer_rsrc((void*)(xbout ? (void*)xbout : (void*)xin), 0, xbout ? TOK * DM * 2 : 0, 0x00020000);
    const __amdgpu_buffer_rsrc_t p2rs = __builtin_amdgcn_make_buffer_rsrc((void*)(part2 ? (void*)part2 : (void*)xin), 0, part2 ? TOK * 32 * 4 : 0, 0x00020000);
    const int bsrc = j * 4;
    const int tile = (int)(uintptr_t)((char*)F.lds) + F.wave * 16384;
    const int wr0 = tile + j * 128 + ((c ^ (j >> 1)) * 16), wr1 = tile + j * 128 + ((c ^ (4 + (j >> 1))) * 16);
    const int trb = (tile + (32 * g + n16) * 128) | ((2 * ((n16 >> 1) & 7) + (g & 1)) * 8);
    for (int s = pl.ord; s < NSL4; s += pl.nx) {
        const __amdgpu_buffer_rsrc_t rs = __builtin_amdgcn_make_buffer_rsrc((void*)(vb + (size_t)s * PEXP * SLB4), 0, PEXP * SLB4, 0x00020000);
        u32x4 rA[16], rB[16], wA0, wA1, wB0, wB1; u32x2 resA, resB;
        unsigned cwA0 = __builtin_amdgcn_raw_buffer_load_b32(wrs, (pl.lw * PE + lane) * 4, 0, 0), cwA1 = __builtin_amdgcn_raw_buffer_load_b32(wrs, (pl.lw * PE + 64 + lane) * 4, 0, 0), cwB0 = 0, cwB1 = 0;
#define PV_ISSUE(r, w0, w1, res, t, cw0, cw1, cn0, cn1) do { __builtin_amdgcn_sched_barrier(0); \
            { const int tn_ = ((t) + pl.nlw < TOK) ? (t) + pl.nlw : (t); cn0 = __builtin_amdgcn_raw_buffer_load_b32(wrs, (tn_ * PE + lane) * 4, 0, 0); cn1 = __builtin_amdgcn_raw_buffer_load_b32(wrs, (tn_ * PE + 64 + lane) * 4, 0, 0); } asm volatile("" ::: "memory"); \
            _Pragma("unroll") for (int b = 0; b < 16; ++b) { const unsigned cwp_ = (unsigned)__builtin_amdgcn_ds_bpermute(bsrc + 32 * (b & 7), (int)(b < 8 ? cw0 : cw1)); \
                r[b] = __builtin_amdgcn_raw_buffer_load_b128(rs, (int)(cwp_ & 0xffffu) * SLB4 + c * 16, 0, 0); } \
            w0 = __builtin_amdgcn_raw_buffer_load_b128(frs, (t) * PE + 16 * g, 0, 0); w1 = __builtin_amdgcn_raw_buffer_load_b128(frs, (t) * PE + 64 + 16 * g, 0, 0); \
            res = __builtin_amdgcn_raw_buffer_load_b64(xirs, ((t) * DM + s * SLW4 + 64 * g + 4 * n16) * 2, 0, 0); \
            asm volatile("" ::: "memory"); __builtin_amdgcn_sched_barrier(0); } while (0)
#define PV_TR(cb, hf, dst) asm volatile("ds_read_b64_tr_b4 %0, %1 offset:%2" : "=&v"(dst) : "v"(trb_ ^ ((cb) * 8)), "i"((hf) * 2048) : "memory")
#define PV_MF(k, lo, hi) acc[k] = __builtin_amdgcn_mfma_scale_f32_16x16x128_f8f6f4(aw_, (i32x8){(int)lo[0], (int)lo[1], (int)hi[0], (int)hi[1], 0, 0, 0, 0}, acc[k], 0, 4, 0, 0x7f7f7f7f, 0, 0x7f7f7f7f)
#define PV_HALF(hh, s0_, s1_) { s0_ = 0.f; s1_ = 0.f; \
            _Pragma("unroll") for (int kk = 0; kk < 2; ++kk) { u32x2 l0, h0, l1, h1, l2, h2, l3, h3; f32x4 acc[4]; \
                _Pragma("unroll") for (int k = 0; k < 4; ++k) acc[k] = (f32x4){0.f, 0.f, 0.f, 0.f}; \
                PV_TR(8 * hh + 4 * kk + 0, 0, l0); PV_TR(8 * hh + 4 * kk + 0, 1, h0); PV_TR(8 * hh + 4 * kk + 1, 0, l1); PV_TR(8 * hh + 4 * kk + 1, 1, h1); \
                PV_TR(8 * hh + 4 * kk + 2, 0, l2); PV_TR(8 * hh + 4 * kk + 2, 1, h2); PV_TR(8 * hh + 4 * kk + 3, 0, l3); PV_TR(8 * hh + 4 * kk + 3, 1, h3); \
                asm volatile("s_waitcnt lgkmcnt(0)" ::: "memory"); SBAR(); \
                PV_MF(0, l0, h0); PV_MF(1, l1, h1); PV_MF(2, l2, h2); PV_MF(3, l3, h3); \
                asm volatile("" : "+v"(acc[0][0]), "+v"(acc[1][0]), "+v"(acc[2][0]), "+v"(acc[3][0]) : "v"(l0), "v"(h0), "v"(l1), "v"(h1), "v"(l2), "v"(h2), "v"(l3), "v"(h3)); \
                s0_ = (g == 2 * kk) ? acc[0][0] : s0_; s1_ = (g == 2 * kk) ? acc[1][0] : s1_; s0_ = (g == 2 * kk + 1) ? acc[2][0] : s0_; s1_ = (g == 2 * kk + 1) ? acc[3][0] : s1_; } }
#define PV_COMPUTE(r, w0, w1, res, t, valid) do { \
            _Pragma("unroll") for (int b = 0; b < 16; ++b) { const int ad_ = ((b & 1) ? wr1 : wr0) + 1024 * b; \
                if ((b >> 2) & 1) { *(LAS u32x2*)(uintptr_t)(unsigned)(ad_ + 8) = (u32x2){r[b].x, r[b].y}; *(LAS u32x2*)(uintptr_t)(unsigned)(ad_) = (u32x2){r[b].z, r[b].w}; } \
                else *(LAS u32x4*)(uintptr_t)(unsigned)(ad_) = r[b]; } \
            asm volatile("s_waitcnt lgkmcnt(0)" ::: "memory"); \
            int trb_ = trb; asm volatile("" : "+v"(trb_));            \
            const i32x8 aw_ = {(int)w0.x, (int)w0.y, (int)w0.z, (int)w0.w, (int)w1.x, (int)w1.y, (int)w1.z, (int)w1.w}; \
            float q0, q1, q2, q3; \
            PV_HALF(0, q0, q1) PV_HALF(1, q2, q3) \
            const float sc_ = 1.0f / (PEER_V4_SCALE * PEER_W_SCALE); \
              \
            const float v0 = fmaf(q0, sc_, __uint_as_float(res.x << 16)), v1 = fmaf(q1, sc_, __uint_as_float(res.x & 0xffff0000u)), v2 = fmaf(q2, sc_, __uint_as_float(res.y << 16)), v3 = fmaf(q3, sc_, __uint_as_float(res.y & 0xffff0000u)); \
            const int o_ = (valid) ? (t) * DM + s * SLW4 + 64 * g + 4 * n16 : 0x0ffffff0; \
            __builtin_amdgcn_raw_buffer_store_b128((u32x4){__float_as_uint(v0), __float_as_uint(v1), __float_as_uint(v2), __float_as_uint(v3)}, xors, o_ * 4, 0, 0); \
            __builtin_amdgcn_raw_buffer_store_b64((u32x2){cvtpk(v0, v1), cvtpk(v2, v3)}, xbrs, o_ * 2, 0, 0); \
            if (part2) { const float ss = row_sum16((v0 * v0 + v1 * v1) + (v2 * v2 + v3 * v3));            \
                __builtin_amdgcn_raw_buffer_store_b32(__float_as_uint(ss), p2rs, (n16 == 0 && (valid)) ? ((t) * 32 + s + 8 * g) * 4 : 0x7ffffff0, 0, 0); } \
            asm volatile("s_waitcnt lgkmcnt(0)" ::: "memory"); } while (0)
        PV_ISSUE(rA, wA0, wA1, resA, pl.lw, cwA0, cwA1, cwB0, cwB1);
        for (int t = pl.lw; t < TOK; t += 2 * pl.nlw) {
            const bool vB = t + pl.nlw < TOK; const int tB = vB ? t + pl.nlw : t, tA2 = (t + 2 * pl.nlw < TOK) ? t + 2 * pl.nlw : t;
            PV_ISSUE(rB, wB0, wB1, resB, tB, cwB0, cwB1, cwA0, cwA1);
            PV_COMPUTE(rA, wA0, wA1, resA, t, true);
            PV_ISSUE(rA, wA0, wA1, resA, tA2, cwA0, cwA1, cwB0, cwB1);
            PV_COMPUTE(rB, wB0, wB1, resB, tB, vB);
        }
#undef PV_ISSUE
#undef PV_TR
#undef PV_MF
#undef PV_HALF
#undef PV_COMPUTE
    }
}
}
#ifndef REP_MASK
#define REP_MASK 0
#endif
#if REP_MASK == 0
#define REPS(i) if (constexpr int rep_ = 0; true)
#else
#define REPS(i) for (int rep_ = 0; rep_ < 1 + ((REP_MASK >> (i)) & 1); ++rep_)
#endif
#ifndef DBG_STAGE
#define DBG_STAGE 0
#endif
#ifndef PG8_WGM_IN
#define PG8_WGM_IN 8
#endif
#ifndef PG8_WGM_AIN
#define PG8_WGM_AIN PG8_WGM
#endif
struct Args { const float* in[16]; float* out; unsigned char* ws; int pad0, pad1; };
__global__ void __launch_bounds__(NTHREADS, 2) fwd_megakernel(Args args) {
    extern __shared__ __attribute__((aligned(16))) unsigned char lds[];
    cg::grid_group grid = cg::this_grid();
    Frame F;
    F.lds = (LAS unsigned char*)lds;
    F.MISC = (volatile LAS unsigned*)(F.lds + MISC_OFF);
    F.tid = threadIdx.x; F.lane = F.tid & 63; F.wave = __builtin_amdgcn_readfirstlane(F.tid >> 6);
    F.G = gridDim.x; F.ws = (GAS unsigned char*)args.ws; F.out = (GAS float*)args.out;
#pragma unroll
    for (int i = 0; i < 16; ++i) F.in[i] = (const GAS float*)args.in[i];
    F.ctl = (gu32*)((GAS unsigned char*)args.ws + WS_CTL);
    for (int u = F.tid; u < (LDS_BYTES - LDSCTL_OFF) / 4; u += NTHREADS) ((LAS unsigned*)(F.lds + LDSCTL_OFF))[u] = 0u;
    __syncthreads();
    XcdBarrier bar = xcd_barrier_post((unsigned*)(F.ctl + CW_BAR), F.MISC + 8);
    if (F.tid == 0) F.MISC[10] = xb_add((unsigned*)(F.ctl + CW_RANK + 64 * bar.x), 1u);
#define GRID_BAR() do { xcd_barrier(bar); PHASE_BEGIN(); } while (0)
#define PLACE() pg::Place{(int)F.MISC[12], (int)F.MISC[11], (int)F.MISC[10] * NWAVES + F.wave, (int)F.MISC[13] * NWAVES}
#define PBUF ((float*)(ws + WS_PROJ))
#define PHASE_BEGIN() do { const int t_ = opaque_tid(); F.tid = t_; F.lane = t_ & 63; F.wave = __builtin_amdgcn_readfirstlane(t_ >> 6); GAS unsigned char* w_ = (GAS unsigned char*)args.ws; asm volatile("" : "+s"(w_)); ws = w_; F.ws = ws; } while (0)
    GAS unsigned char* ws = (GAS unsigned char*)args.ws;
#define XB0 ((bf16*)(ws + WS_XB0))
#define XB1 ((bf16*)(ws + WS_XB1))
#define XR ((float*)(ws + WS_XR))
#define PROJ ((bf16*)(ws + WS_PROJ))
#define PQ ((bf16*)(ws + WS_HS))
#define HB ((bf16*)(ws + WS_HB))
#define PART ((float*)(ws + WS_PART))
#define rstd0 ((float*)(ws + WS_RSTD))
#define rstd2 ((float*)(ws + WS_RSTD) + TOK)
    const int bid = (int)blockIdx.x;
    constexpr int STG = DBG_STAGE;

    REPS(0) { p0_prologue(F); VM_WAIT(); __syncthreads(); xcd_barrier(bar); PHASE_BEGIN(); }
    if (args.pad0 != 0) grid.sync();
    if (F.tid == 0) {
        unsigned nx = 0, ord = 0, nloc = 1;
        for (unsigned j = 0; j < 16; ++j) { const unsigned cnt = xb_ld((unsigned*)(F.ctl + CW_BAR) + XB_XCNT(j)); if (cnt) { if (j < bar.x) ++ord; ++nx; } if (j == bar.x) nloc = cnt ? cnt : 1; }
        F.MISC[11] = nx ? nx : 1; F.MISC[12] = ord; F.MISC[13] = nloc;
    }
    __syncthreads();
    if (STG >= 0) {
REPS(1) {
        if (bid < 64) ml::scan(F, bid >> 1, bid & 1);
    {
        pg8::Gemm g{XB0, (const bf16*)(ws + WS_WIN), TOK, MPROJ, DM}; pg8::StaticOrder S; S.init(TOK, MPROJ, F.G, bid, PG8_WGM_IN);
        pg8::EpiScaleBf16 E{PROJ, MPROJ, rstd0, 4096};
        pg8::gemm_phase<pg8::EpiScaleBf16, pg8::StaticOrder, PG8_ALIGN, PG8_SP2>(F.lds, g, S, E);
    }
    GRID_BAR();
    }
#ifdef REP_BAR
    for (int rb_ = 0; rb_ < REP_BAR; ++rb_) GRID_BAR();
#endif
REPS(2) {
        ml2::phase<0>(F);
#ifdef ML_PROBE
        xcd_barrier(bar); PHASE_BEGIN(); ml2::phase<ML_PROBE + 1>(F);
#endif
    GRID_BAR();
    }
REPS(4) {
        {
        pg8::Gemm g{HB, (const bf16*)(ws + WS_WOUT), TOK, DM, DM}; pg8::StaticOrder S; S.init(TOK, DM, F.G, bid);
        pg8::EpiResidT<true, STG == 1> E{(const void*)XB0, XR, XB1, PART, DM};
        pg8::gemm_phase<pg8::EpiResidT<true, STG == 1>, pg8::StaticOrder, PG8_ALIGN, PG8_SP2>(F.lds, g, S, E);
    }
    GRID_BAR();
    }
    if (STG == 0 || STG >= 2) {
REPS(5) {
        {
        pg8::Gemm g{XB1, (const bf16*)(ws + WS_WQ), TOK, DM, DM}; pg8::StaticOrder S; S.init(TOK, DM, F.G, bid);
        pg8::EpiScaleBf16 E{PQ, DM, nullptr, 1 << 30};
        pg8::gemm_phase<pg8::EpiScaleBf16, pg8::StaticOrder, PG8_ALIGN, PG8_SP2>(F.lds, g, S, E);
    }
    GRID_BAR();
    }
REPS(6) {
        tk::phase<0>(F, 0, PQ);
#ifdef TK_PROBE
    xcd_barrier(bar); PHASE_BEGIN(); tk::phase<TK_PROBE + 1>(F, 0, PQ);
#endif
    GRID_BAR();
    }
REPS(7) { const pg::Place pl = PLACE(); pg::phase_u4<0>(F, pl, 0, XB1, PBUF); GRID_BAR(); }
#ifdef PU_PROBE
    { const pg::Place pl = PLACE(); pg::phase_u4<PU_PROBE>(F, pl, 0, XB1, (float*)(ws + WS_PSCR)); GRID_BAR(); }
#endif
    REPS(15) { pg::phase_r<pg::NSL4, 1>(F, PBUF); GRID_BAR(); }
    REPS(16) {
        { const pg::Place pl = PLACE(); pg::phase_v4(F, pl, 0, XB1, nullptr, XB0, PART); }
    GRID_BAR();
    }
    if (STG == 0 || STG >= 3) {
REPS(8) {
        {
        pg8::Gemm g{XB0, (const bf16*)(ws + WS_AIN), TOK, APROJ, DM}; pg8::StaticOrder S; S.init(TOK, APROJ, F.G, bid, PG8_WGM_AIN);
        pg8::EpiScaleBf16 E{PROJ, APROJ, nullptr, 1 << 30};
        pg8::gemm_phase<pg8::EpiScaleBf16, pg8::StaticOrder, PG8_ALIGN, PG8_SP2>(F.lds, g, S, E);
    }
    GRID_BAR();
    }
    at::rope_phase(F);
    GRID_BAR();
REPS(10) {
        at::phase(F);
    GRID_BAR();
    }
REPS(11) {
        {
        pg8::Gemm g{HB, (const bf16*)(ws + WS_AOUT), TOK, DM, DM}; pg8::StaticOrder S; S.init(TOK, DM, F.G, bid);
        pg8::EpiResidT<true, STG == 3> E{(const void*)XB0, XR, XB1, PART, DM};
        pg8::gemm_phase<pg8::EpiResidT<true, STG == 3>, pg8::StaticOrder, PG8_ALIGN, PG8_SP2>(F.lds, g, S, E);
    }
    GRID_BAR();
    }
    if (STG == 0) {
REPS(12) {
        {
        pg8::Gemm g{XB1, (const bf16*)(ws + WS_WQ) + (size_t)DM * DM, TOK, DM, DM}; pg8::StaticOrder S; S.init(TOK, DM, F.G, bid);
        pg8::EpiScaleBf16 E{PQ, DM, nullptr, 1 << 30};
        pg8::gemm_phase<pg8::EpiScaleBf16, pg8::StaticOrder, PG8_ALIGN, PG8_SP2>(F.lds, g, S, E);
    }
    GRID_BAR();
    }
REPS(13) {
        tk::phase<0>(F, 1, PQ);
    GRID_BAR();
    }
    REPS(14) { const pg::Place pl = PLACE(); pg::phase_u4<0>(F, pl, 1, XB1, PBUF); GRID_BAR(); }
    REPS(17) { pg::phase_r<pg::NSL4, 1>(F, PBUF); GRID_BAR(); }
    REPS(18) { { const pg::Place pl = PLACE(); pg::phase_v4(F, pl, 1, XB1, (float*)F.out, nullptr, nullptr); } if (rep_ + 1 < 1 + ((REP_MASK >> 18) & 1)) GRID_BAR(); }
    }
    }
    }
    }
#if DBG_STAGE == 1 || DBG_STAGE == 3 || DBG_STAGE == -1
    {
        const float* src = (DBG_STAGE == -1) ? (const float*)F.in[0] : (const float*)XR;
        const size_t gtid = (size_t)blockIdx.x * NTHREADS + F.tid, gthreads = (size_t)F.G * NTHREADS;
        for (size_t i = gtid; i < (size_t)TOK * DM / 4; i += gthreads) ((f32x4*)F.out)[i] = ((const f32x4*)src)[i];
    }
#endif
}

extern "C" void kernel_launch(void* const* d_in, const int* in_sizes, int n_in, void* d_out, int out_size, void* d_ws, size_t ws_size, hipStream_t stream) {
    static int grid = 0;
    if (grid == 0) {
        if (n_in != 16 || in_sizes[0] != TOK * DM || out_size != TOK * DM || ws_size < WS_END) {
            fprintf(stderr, "kernel_launch: unexpected shapes: n_in %d in0 %d out %d ws %zu (need >= %zu)\n", n_in, n_in > 0 ? in_sizes[0] : -1, out_size, ws_size, (size_t)WS_END); grid = -1; return; }
        int dev = 0, cus = 0, per_cu = 0;
        if (hipGetDevice(&dev) != hipSuccess || hipDeviceGetAttribute(&cus, hipDeviceAttributeMultiprocessorCount, dev) != hipSuccess) { fprintf(stderr, "kernel_launch: device query failed\n"); grid = -1; return; }
        if (hipFuncSetAttribute((const void*)fwd_megakernel, hipFuncAttributeMaxDynamicSharedMemorySize, LDS_BYTES) != hipSuccess) { fprintf(stderr, "kernel_launch: hipFuncSetAttribute failed\n"); grid = -1; return; }
        if (hipOccupancyMaxActiveBlocksPerMultiprocessor(&per_cu, (const void*)fwd_megakernel, NTHREADS, LDS_BYTES) != hipSuccess || per_cu < 1) {
            fprintf(stderr, "kernel_launch: occupancy query reports %d workgroups per CU\n", per_cu); (void)hipGetLastError(); per_cu = 1; }
        grid = cus;
        fprintf(stderr, "kernel_launch: %d CUs, occupancy %d per CU, grid %d\n", cus, per_cu, grid);
    }
    if (grid < 0) return;
    if (hipMemsetAsync((char*)d_ws + WS_CTL, 0, CTL_ZERO_BYTES, stream) != hipSuccess) { fprintf(stderr, "kernel_launch: memset failed\n"); return; }
    Args a{};
    for (int i = 0; i < 16; ++i) a.in[i] = (const float*)d_in[i];
    a.out = (float*)d_out; a.ws = (unsigned char*)d_ws;
    void* kargs[] = {&a};
    const hipError_t e = hipLaunchCooperativeKernel((const void*)fwd_megakernel, dim3(grid), dim3(NTHREADS), kargs, LDS_BYTES, stream);
    if (e != hipSuccess) fprintf(stderr, "kernel_launch: cooperative launch failed: %s (grid %d)\n", hipGetErrorString(e), grid);
}
```
